# Optimizing an MI355X kernel written in HIP

```python
import jax, jax.numpy as jnp
from jax import lax
import numpy as np

D_MODEL = 1024
BATCH = 8
SEQ = 4096
DEPTH = 2

GRID_W = 64
CTX_LEN = 256
EPS = 1e-6
NEG_INF = -1e30

LRU_WIDTH = D_MODEL
LRU_HEADS = 16
LRU_BLOCK = LRU_WIDTH // LRU_HEADS
LRU_C = 8.0
CONV_W = 4
CONV_LEFT = 2
FNET_WIDTH = D_MODEL
FNET_GROUPS = 8
FNET_GROUP_DIM = FNET_WIDTH // FNET_GROUPS
L0_IN_WIDTH = 2 * LRU_WIDTH + 2 * FNET_WIDTH
L0_MIX_WIDTH = LRU_WIDTH + FNET_WIDTH
HEAD_DIM = 64
N_Q_HEADS = D_MODEL // HEAD_DIM
N_KV_HEADS = 4
GQA_GROUP = N_Q_HEADS // N_KV_HEADS
Q_WIDTH = N_Q_HEADS * HEAD_DIM
KV_WIDTH = N_KV_HEADS * HEAD_DIM
L1_IN_WIDTH = 2 * Q_WIDTH + 2 * KV_WIDTH
WINDOW = 128
BLOCK = 128
ROPE_BASE = 10000.0

kernel_name = "hybrid_rglru_fourier_window_gqa_ctx_prefix"


def rms_norm(x, g):
    xf = x.astype(jnp.float32)
    y = xf * lax.rsqrt(jnp.mean(xf * xf, axis=-1, keepdims=True) + EPS)
    return (y * g.astype(jnp.float32)).astype(x.dtype)


def modulation(cvec, w_mod, b_mod):
    m = jax.nn.silu(cvec) @ w_mod + b_mod
    return jnp.split(m, 3, axis=-1)


def centred_depthwise_conv(u, w, b):
    n = u.shape[1]
    up = jnp.pad(u, ((0, 0), (CONV_LEFT, CONV_W - 1 - CONV_LEFT), (0, 0)))
    out = b + up[:, 0:n] * w[0]
    for k in range(1, CONV_W):
        out = out + up[:, k:k + n] * w[k]
    return out


def block_diag_linear(u, w, b):
    bsz, n, _ = u.shape
    y = jnp.einsum('bnhd,hde->bnhe', u.reshape(bsz, n, LRU_HEADS, LRU_BLOCK), w)
    return y.reshape(bsz, n, LRU_WIDTH) + b


def rglru_coeffs(u, w_a, b_a, w_x, b_x, lam):
    uf = u.astype(jnp.float32)
    r = jax.nn.sigmoid(block_diag_linear(uf, w_a.astype(jnp.float32), b_a.astype(jnp.float32)))
    i = jax.nn.sigmoid(block_diag_linear(uf, w_x.astype(jnp.float32), b_x.astype(jnp.float32)))
    log_a = -LRU_C * r * jax.nn.softplus(-lam.astype(jnp.float32))
    a = jnp.exp(log_a)
    bterm = jnp.sqrt(-jnp.expm1(2.0 * log_a)) * (i * uf)
    return a, bterm


def linear_scan(a, b, h0):
    b = b.at[:, 0].add(a[:, 0] * h0)

    def combine(lft, rgt):
        return (lft[0] * rgt[0], rgt[0] * lft[1] + rgt[1])

    _, h = lax.associative_scan(combine, (a, b), axis=1)
    return h


def rglru_bidirectional(u_lat, u_ctx, w_a, b_a, w_x, b_x, lam):
    y_lat = None
    y_ctx = None
    for d in range(2):
        ul = u_lat if d == 0 else jnp.flip(u_lat, axis=1)
        uc = u_ctx if d == 0 else jnp.flip(u_ctx, axis=1)
        a_c, b_c = rglru_coeffs(uc, w_a[d], b_a[d], w_x[d], b_x[d], lam[d])
        h_c = linear_scan(a_c, b_c, jnp.zeros_like(b_c[:, 0]))
        a_l, b_l = rglru_coeffs(ul, w_a[d], b_a[d], w_x[d], b_x[d], lam[d])
        h_l = linear_scan(a_l, b_l, h_c[:, -1])
        if d == 1:
            h_c = jnp.flip(h_c, axis=1)
            h_l = jnp.flip(h_l, axis=1)
        y_lat = h_l if y_lat is None else y_lat + h_l
        y_ctx = h_c if y_ctx is None else y_ctx + h_c
    return y_lat, y_ctx


def fourier_mix(u, w_f, b_f):
    bsz, n, _ = u.shape
    ug = u.astype(jnp.float32).reshape(bsz, n, FNET_GROUPS, FNET_GROUP_DIM)
    f = jnp.fft.fft2(ug, axes=(1, 3), norm="ortho").real
    y = jnp.einsum('bngd,gde->bnge', f, w_f.astype(jnp.float32)).reshape(bsz, n, FNET_WIDTH)
    return (y + b_f.astype(jnp.float32)).astype(u.dtype)


def lru_fourier_layer(h_lat, h_ctx, w_in, w_conv, b_conv, w_a, b_a, w_x, b_x, lam,
                      w_f, b_f, w_out, with_ctx_out):
    o1, o2, o3 = LRU_WIDTH, 2 * LRU_WIDTH, 2 * LRU_WIDTH + FNET_WIDTH
    z = h_lat @ w_in
    u_l, g_l, f_l, gf_l = z[..., :o1], z[..., o1:o2], z[..., o2:o3], z[..., o3:]
    if with_ctx_out:
        zc = h_ctx @ w_in
        u_c, g_c, f_c, gf_c = zc[..., :o1], zc[..., o1:o2], zc[..., o2:o3], zc[..., o3:]
    else:
        u_c = h_ctx @ w_in[:, :o1]
    u_l = centred_depthwise_conv(u_l, w_conv, b_conv)
    u_c = centred_depthwise_conv(u_c, w_conv, b_conv)
    r_l, r_c = rglru_bidirectional(u_l, u_c, w_a, b_a, w_x, b_x, lam)
    mix_l = jnp.concatenate([r_l * jax.nn.silu(g_l), fourier_mix(f_l, w_f, b_f) * jax.nn.silu(gf_l)], axis=-1)
    y_lat = mix_l @ w_out
    y_ctx = None
    if with_ctx_out:
        mix_c = jnp.concatenate([r_c * jax.nn.silu(g_c), fourier_mix(f_c, w_f, b_f) * jax.nn.silu(gf_c)], axis=-1)
        y_ctx = mix_c @ w_out
    return y_lat, y_ctx


def axial_rope_tables(n):
    t = jnp.arange(n)
    row = (t // GRID_W).astype(jnp.float32)
    col = (t % GRID_W).astype(jnp.float32)
    half = HEAD_DIM // 2
    freqs = ROPE_BASE ** (-jnp.arange(0, half, 2, dtype=jnp.float32) / half)
    ar = row[:, None] * freqs[None, :]
    ac = col[:, None] * freqs[None, :]
    return jnp.cos(ar), jnp.sin(ar), jnp.cos(ac), jnp.sin(ac)


def rope_1d(x, cos, sin):
    x1, x2 = jnp.split(x, 2, axis=-1)
    cos = cos[None, :, None, :].astype(x.dtype)
    sin = sin[None, :, None, :].astype(x.dtype)
    return jnp.concatenate([x1 * cos - x2 * sin, x2 * cos + x1 * sin], axis=-1)


def axial_rope(x, cos_r, sin_r, cos_c, sin_c):
    half = HEAD_DIM // 2
    return jnp.concatenate([rope_1d(x[..., :half], cos_r, sin_r),
                            rope_1d(x[..., half:], cos_c, sin_c)], axis=-1)


def window_gqa_layer(h_lat, h_ctx, w_in, sink, w_out, with_ctx_out):
    bsz, n, _ = h_lat.shape
    n_ctx = h_ctx.shape[1]
    nb = n // BLOCK
    scale = HEAD_DIM ** -0.5
    o1, o2, o3 = Q_WIDTH, Q_WIDTH + KV_WIDTH, Q_WIDTH + 2 * KV_WIDTH
    z = h_lat @ w_in
    q = z[..., :o1].reshape(bsz, n, N_Q_HEADS, HEAD_DIM)
    k = z[..., o1:o2].reshape(bsz, n, N_KV_HEADS, HEAD_DIM)
    v = z[..., o2:o3].reshape(bsz, n, N_KV_HEADS, HEAD_DIM)
    g = z[..., o3:]
    cos_r, sin_r, cos_c, sin_c = axial_rope_tables(n)
    q = axial_rope(q, cos_r, sin_r, cos_c, sin_c)
    k = axial_rope(k, cos_r, sin_r, cos_c, sin_c)
    zc = h_ctx @ w_in[:, o1:o3]
    k_c = zc[..., :KV_WIDTH].reshape(bsz, n_ctx, N_KV_HEADS, HEAD_DIM)
    v_c = zc[..., KV_WIDTH:].reshape(bsz, n_ctx, N_KV_HEADS, HEAD_DIM)
    sink_f = sink.astype(jnp.float32).reshape(1, 1, N_KV_HEADS, GQA_GROUP, 1, 1)

    qb = q.reshape(bsz, nb, BLOCK, N_KV_HEADS, GQA_GROUP, HEAD_DIM)
    pad = ((0, 0), (BLOCK, BLOCK), (0, 0), (0, 0))
    kp = jnp.pad(k, pad).reshape(bsz, nb + 2, BLOCK, N_KV_HEADS, HEAD_DIM)
    vp = jnp.pad(v, pad).reshape(bsz, nb + 2, BLOCK, N_KV_HEADS, HEAD_DIM)
    kw = jnp.concatenate([kp[:, :-2], kp[:, 1:-1], kp[:, 2:]], axis=2)
    vw = jnp.concatenate([vp[:, :-2], vp[:, 1:-1], vp[:, 2:]], axis=2)
    s_lat = jnp.einsum('bnqkgd,bnskd->bnkgqs', qb, kw).astype(jnp.float32) * scale
    blk = jnp.arange(nb)[:, None, None]
    qpos = blk * BLOCK + jnp.arange(BLOCK)[None, :, None]
    kpos = (blk - 1) * BLOCK + jnp.arange(3 * BLOCK)[None, None, :]
    valid = (jnp.abs(qpos - kpos) <= WINDOW) & (kpos >= 0) & (kpos < n)
    s_lat = jnp.where(valid[None, :, None, None], s_lat, NEG_INF)
    s_ctx = jnp.einsum('bnqkgd,bskd->bnkgqs', qb, k_c).astype(jnp.float32) * scale
    s_sink = jnp.broadcast_to(sink_f, s_lat.shape[:-1] + (1,))
    probs = jax.nn.softmax(jnp.concatenate([s_lat, s_ctx, s_sink], axis=-1), axis=-1)
    p_lat = probs[..., :3 * BLOCK].astype(v.dtype)
    p_ctx = probs[..., 3 * BLOCK:3 * BLOCK + n_ctx].astype(v.dtype)
    o = (jnp.einsum('bnkgqs,bnskd->bnqkgd', p_lat, vw)
         + jnp.einsum('bnkgqs,bskd->bnqkgd', p_ctx, v_c)).reshape(bsz, n, Q_WIDTH)
    y_lat = (o * jax.nn.silu(g)) @ w_out

    y_ctx = None
    if with_ctx_out:
        q_c = (h_ctx @ w_in[:, :o1]).reshape(bsz, n_ctx, N_KV_HEADS, GQA_GROUP, HEAD_DIM)
        g_c = h_ctx @ w_in[:, o3:]
        s_c = jnp.einsum('bqkgd,bskd->bkgqs', q_c, k_c).astype(jnp.float32) * scale
        s_cs = jnp.broadcast_to(sink_f[0], s_c.shape[:-1] + (1,))
        pr = jax.nn.softmax(jnp.concatenate([s_c, s_cs], axis=-1), axis=-1)[..., :n_ctx]
        o_c = jnp.einsum('bkgqs,bskd->bqkgd', pr.astype(v_c.dtype), v_c).reshape(bsz, n_ctx, Q_WIDTH)
        y_ctx = (o_c * jax.nn.silu(g_c)) @ w_out
    return y_lat, y_ctx


def setup_inputs(seed: int = 0) -> dict:
    key = jax.random.key(seed)
    ks = jax.random.split(key, 32)
    f32 = jnp.float32
    d = D_MODEL

    def nrm(k, shape, s):
        return jax.random.normal(k, shape, f32) * s

    a0 = jax.random.uniform(ks[13], (2, LRU_WIDTH), f32, 0.9, 0.999)
    return {
        "x": nrm(ks[0], (BATCH, SEQ, d), 1.0),
        "c": nrm(ks[1], (BATCH, d), 1.0),
        "ctx": nrm(ks[2], (BATCH, CTX_LEN, d), 1.0),
        "c_ctx": nrm(ks[3], (d,), 1.0),
        "l0_w_mod": nrm(ks[4], (d, 3 * d), 0.5 * d ** -0.5),
        "l0_b_mod": nrm(ks[5], (3 * d,), 0.01),
        "l0_g_pre": 1.0 + nrm(ks[6], (d,), 0.05),
        "l0_g_post": 1.0 + nrm(ks[7], (d,), 0.05),
        "l0_w_in": nrm(ks[8], (d, L0_IN_WIDTH), d ** -0.5),
        "l0_w_conv": nrm(ks[9], (CONV_W, LRU_WIDTH), CONV_W ** -0.5),
        "l0_b_conv": nrm(ks[10], (LRU_WIDTH,), 0.01),
        "l0_w_a": nrm(ks[11], (2, LRU_HEADS, LRU_BLOCK, LRU_BLOCK), LRU_BLOCK ** -0.5),
        "l0_b_a": nrm(ks[12], (2, LRU_WIDTH), 0.01),
        "l0_w_x": nrm(ks[14], (2, LRU_HEADS, LRU_BLOCK, LRU_BLOCK), LRU_BLOCK ** -0.5),
        "l0_b_x": nrm(ks[15], (2, LRU_WIDTH), 0.01),
        "l0_lam": jnp.log(a0) - jnp.log1p(-a0),
        "l0_w_f": nrm(ks[16], (FNET_GROUPS, FNET_GROUP_DIM, FNET_GROUP_DIM), FNET_GROUP_DIM ** -0.5),
        "l0_b_f": nrm(ks[17], (FNET_WIDTH,), 0.01),
        "l0_w_out": nrm(ks[18], (L0_MIX_WIDTH, d), L0_MIX_WIDTH ** -0.5),
        "l1_w_mod": nrm(ks[19], (d, 3 * d), 0.5 * d ** -0.5),
        "l1_b_mod": nrm(ks[20], (3 * d,), 0.01),
        "l1_g_pre": 1.0 + nrm(ks[21], (d,), 0.05),
        "l1_g_post": 1.0 + nrm(ks[22], (d,), 0.05),
        "l1_w_in": nrm(ks[23], (d, L1_IN_WIDTH), d ** -0.5),
        "l1_sink": nrm(ks[24], (N_Q_HEADS,), 1.0),
        "l1_w_out": nrm(ks[25], (Q_WIDTH, d), Q_WIDTH ** -0.5),
    }


def reference(x, c, ctx, c_ctx,
              l0_w_mod, l0_b_mod, l0_g_pre, l0_g_post, l0_w_in, l0_w_conv, l0_b_conv,
              l0_w_a, l0_b_a, l0_w_x, l0_b_x, l0_lam, l0_w_f, l0_b_f, l0_w_out,
              l1_w_mod, l1_b_mod, l1_g_pre, l1_g_post, l1_w_in, l1_sink, l1_w_out):
    layers = (
        dict(w_mod=l0_w_mod, b_mod=l0_b_mod, g_pre=l0_g_pre, g_post=l0_g_post),
        dict(w_mod=l1_w_mod, b_mod=l1_b_mod, g_pre=l1_g_pre, g_post=l1_g_post),
    )
    for layer in range(DEPTH):
        p = layers[layer]
        with_ctx_out = layer < DEPTH - 1
        sh_l, sc_l, gt_l = modulation(c, p["w_mod"], p["b_mod"])
        sh_c, sc_c, gt_c = modulation(c_ctx, p["w_mod"], p["b_mod"])
        h_lat = rms_norm(x, p["g_pre"]) * (1.0 + sc_l[:, None, :]) + sh_l[:, None, :]
        h_ctx = rms_norm(ctx, p["g_pre"]) * (1.0 + sc_c) + sh_c
        if layer % 2 == 0:
            y_lat, y_ctx = lru_fourier_layer(h_lat, h_ctx, l0_w_in, l0_w_conv, l0_b_conv,
                                             l0_w_a, l0_b_a, l0_w_x, l0_b_x, l0_lam,
                                             l0_w_f, l0_b_f, l0_w_out, with_ctx_out)
        else:
            y_lat, y_ctx = window_gqa_layer(h_lat, h_ctx, l1_w_in, l1_sink, l1_w_out, with_ctx_out)
        x = x + gt_l[:, None, :] * rms_norm(y_lat, p["g_post"])
        if with_ctx_out:
            ctx = ctx + gt_c * rms_norm(y_ctx, p["g_post"])
    return x
```

```cpp
#include <hip/hip_runtime.h>
#include <hip/hip_cooperative_groups.h>
#include <cstdio>
namespace cg = cooperative_groups;

typedef unsigned short bf16_t;
typedef short bf16x8 __attribute__((ext_vector_type(8)));
typedef float f32x4 __attribute__((ext_vector_type(4)));
#define DEVI __device__ __forceinline__

constexpr int NB = 8, SEQ = 4096, CTX = 256, DM = 1024, TPB = SEQ + CTX  , NR = NB * TPB  ;
constexpr int NCH = TPB / 64;
constexpr float LOG2E = 1.4426950408889634f;

constexpr size_t MiB = 1ull << 20;
constexpr size_t OFF_A = 0;
constexpr size_t OFF_B = 68 * MiB;
constexpr size_t OFF_C = 136 * MiB;
constexpr size_t OFF_D = 204 * MiB;
constexpr size_t OFF_E = 272 * MiB;
constexpr size_t OFF_W0T = 408 * MiB;
constexpr size_t OFF_WO0T = 418 * MiB;
constexpr size_t OFF_W1T = 422 * MiB;
constexpr size_t OFF_WO1T = 427 * MiB;
constexpr size_t OFF_DL = 429 * MiB;
constexpr size_t OFF_QF = OFF_DL + 16 * MiB;
constexpr size_t OFF_DC = 493 * MiB;
constexpr size_t OFF_WG = OFF_DC + 256 * 1024;
constexpr size_t OFF_WCS = 494 * MiB;
constexpr size_t OFF_MODS = 495 * MiB;
constexpr size_t OFF_ROPE = OFF_MODS + 256 * 1024;
constexpr size_t OFF_AGG = 496 * MiB;

struct P {
    const float *x, *c, *ctx, *c_ctx;
    const float *w_mod0, *b_mod0, *g_pre0, *g_post0, *w_in0, *w_conv, *b_conv, *w_a, *b_a, *w_x, *b_x, *lam, *w_f, *b_f, *w_out0;
    const float *w_mod1, *b_mod1, *g_pre1, *g_post1, *w_in1, *sink, *w_out1;
    float* out;
    char* ws;
};

DEVI int opaque_tid() { int t = (int)threadIdx.x; asm volatile("" : "+v"(t)); return t; }
DEVI float bf2f(bf16_t h) { return __uint_as_float(((unsigned)h) << 16); }
typedef float f32x2 __attribute__((ext_vector_type(2)));
typedef __bf16 bf16x2_t __attribute__((ext_vector_type(2)));
DEVI unsigned pk2(float lo, float hi) { f32x2 v = {lo, hi}; bf16x2_t b = __builtin_convertvector(v, bf16x2_t); return __builtin_bit_cast(unsigned, b); }
DEVI float bflo(unsigned u) { return __uint_as_float(u << 16); }
DEVI float bfhi(unsigned u) { return __uint_as_float(u & 0xffff0000u); }
DEVI float sigmoidf_(float x) { return __builtin_amdgcn_rcpf(1.0f + __expf(-x)); }
DEVI float siluf_(float x) { return x * sigmoidf_(x); }
DEVI float rowmax4(float v) {
    const auto a = __builtin_amdgcn_permlane32_swap(__float_as_uint(v), __float_as_uint(v), false, false);
    const float m = fmaxf(__uint_as_float(a[0]), __uint_as_float(a[1]));
    const auto b = __builtin_amdgcn_permlane16_swap(__float_as_uint(m), __float_as_uint(m), false, false);
    return fmaxf(__uint_as_float(b[0]), __uint_as_float(b[1]));
}
DEVI float rowsum4(float v) {
    const auto a = __builtin_amdgcn_permlane32_swap(__float_as_uint(v), __float_as_uint(v), false, false);
    const float m = __uint_as_float(a[0]) + __uint_as_float(a[1]);
    const auto b = __builtin_amdgcn_permlane16_swap(__float_as_uint(m), __float_as_uint(m), false, false);
    return __uint_as_float(b[0]) + __uint_as_float(b[1]);
}
DEVI void rowgather4(float v, float (&g)[4]) {
    const auto s16 = __builtin_amdgcn_permlane16_swap(__float_as_uint(v), __float_as_uint(v), false, false);
    const auto se = __builtin_amdgcn_permlane32_swap(s16[0], s16[0], false, false);
    const auto so = __builtin_amdgcn_permlane32_swap(s16[1], s16[1], false, false);
    g[0] = __uint_as_float(se[0]); g[1] = __uint_as_float(so[0]); g[2] = __uint_as_float(se[1]); g[3] = __uint_as_float(so[1]);
}
DEVI float wave_sum(float v) {
#pragma unroll
    for (int o = 32; o > 0; o >>= 1) v += __shfl_xor(v, o);
    return v;
}

template <bool TRANS, class Epi>
DEVI void gemm_tile(const bf16_t* __restrict__ A0, const bf16_t* __restrict__ A1, int ksplit, int lda,
                    const bf16_t* __restrict__ Bt, int ldb, int nk, char* smem, const Epi& epi, int row0, int col0) {
    const int tid = opaque_tid(), lane = tid & 63, w = tid >> 6, wr = w >> 1, wc = w & 1, fr = lane & 15, fq = lane >> 4;
    f32x4 acc[4][4];
#pragma unroll
    for (int m = 0; m < 4; ++m)
#pragma unroll
        for (int n = 0; n < 4; ++n) acc[m][n] = (f32x4){0.f, 0.f, 0.f, 0.f};
    const int srow = w * 8 + (lane >> 3), sch = (lane & 7) ^ ((lane >> 3) & 7);
    const size_t aoff = (size_t)srow * lda + sch * 8, boff = (size_t)srow * ldb + sch * 8;
    const int ldsoff = w * 1024 + lane * 16;
    auto issue = [&](int kt, int buf) {
        const bf16_t* ap = (kt < ksplit ? A0 + (size_t)kt * 64 : A1 + (size_t)(kt - ksplit) * 64) + aoff;
        const bf16_t* bp = Bt + (size_t)kt * 64 + boff;
        char* sa = smem + buf * 32768 + ldsoff;
        char* sb = sa + 16384;
#pragma unroll
        for (int i = 0; i < 4; ++i) __builtin_amdgcn_global_load_lds((const unsigned*)(ap + (size_t)(32 * i) * lda), (unsigned*)(sa + i * 4096), 16, 0, 0);
#pragma unroll
        for (int i = 0; i < 4; ++i) __builtin_amdgcn_global_load_lds((const unsigned*)(bp + (size_t)(32 * i) * ldb), (unsigned*)(sb + i * 4096), 16, 0, 0);
    };
    __syncthreads();
    issue(0, 0);
    asm volatile("s_waitcnt vmcnt(0)" ::: "memory");
    __syncthreads();
    for (int kt = 0; kt < nk; ++kt) {
        const int buf = kt & 1;
        if (kt + 1 < nk) issue(kt + 1, buf ^ 1);
        const char* sa = smem + buf * 32768;
        const char* sb = sa + 16384;
#pragma unroll
        for (int kk = 0; kk < 2; ++kk) {
            bf16x8 af[4], bfr[4];
            const int cho = (((kk * 4 + fq) ^ (fr & 7)) << 4);
#pragma unroll
            for (int m = 0; m < 4; ++m) af[m] = *(const bf16x8*)(sa + (wr * 64 + 16 * m + fr) * 128 + cho);
#pragma unroll
            for (int n = 0; n < 4; ++n) bfr[n] = *(const bf16x8*)(sb + (wc * 64 + 16 * n + fr) * 128 + cho);
            __builtin_amdgcn_s_setprio(1);
#pragma unroll
            for (int m = 0; m < 4; ++m)
#pragma unroll
                for (int n = 0; n < 4; ++n)
                    acc[m][n] = TRANS ? __builtin_amdgcn_mfma_f32_16x16x32_bf16(bfr[n], af[m], acc[m][n], 0, 0, 0)
                                      : __builtin_amdgcn_mfma_f32_16x16x32_bf16(af[m], bfr[n], acc[m][n], 0, 0, 0);
            __builtin_amdgcn_s_setprio(0);
        }
        asm volatile("s_waitcnt vmcnt(0)" ::: "memory");
        __syncthreads();
    }
    epi.template operator()<4>(acc, row0 + wr * 64, col0 + wc * 64, fr, fq);
}

DEVI void tile_map(int L, int nM, int nN, int& pm, int& pn) {
    const int nwg = nM * nN, q = nwg >> 3, r = nwg & 7, xcd = L & 7, off = L >> 3;
    const int wgid = (xcd < r ? xcd * (q + 1) : r * (q + 1) + (xcd - r) * q) + off;
    const int WGM = 8, nig = WGM * nN, gid = wgid / nig, fm = gid * WGM, gsz = (nM - fm) < WGM ? (nM - fm) : WGM;
    pm = fm + ((wgid % nig) % gsz);
    pn = (wgid % nig) / gsz;
}

struct G2Tile { const bf16_t* A; const bf16_t* Bt; int lda, ldb, nk, row0, col0, aux; };
DEVI void g2_issue(const G2Tile& t, int kt, int st, char* smem) {
    const int tid = opaque_tid(), lane = tid & 63, w = tid >> 6;
    const int rr = lane >> 2, sch = (lane & 3) ^ ((lane >> 5) << 1);
    const bf16_t* ap = t.A + (size_t)kt * 32 + (size_t)(w * 16 + rr) * t.lda + sch * 8;
    const bf16_t* bp = t.Bt + (size_t)kt * 32 + (size_t)(w * 16 + rr) * t.ldb + sch * 8;
    char* sa = smem + st * 24576 + w * 1024 + lane * 16;
#pragma unroll
    for (int i = 0; i < 4; ++i) __builtin_amdgcn_global_load_lds((const unsigned*)(ap + (size_t)(64 * i) * t.lda), (unsigned*)(sa + i * 4096), 16, 0, 0);
#pragma unroll
    for (int i = 0; i < 2; ++i) __builtin_amdgcn_global_load_lds((const unsigned*)(bp + (size_t)(64 * i) * t.ldb), (unsigned*)(sa + 16384 + i * 4096), 16, 0, 0);
}
DEVI void g2_prologue(const G2Tile& t, int st, char* smem) {
    g2_issue(t, 0, st, smem);
    g2_issue(t, 1, st == 2 ? 0 : st + 1, smem);
}
template <bool TRANS, class Epi>
DEVI int g2_body(const G2Tile& t, int st, char* smem, bool has_next, const G2Tile& nxt, const Epi& epi) {
    const int tid = opaque_tid(), lane = tid & 63, w = tid >> 6, wr = w >> 1, wc = w & 1, fr = lane & 15, fq = lane >> 4;
    f32x4 acc[8][4];
#pragma unroll
    for (int m = 0; m < 8; ++m)
#pragma unroll
        for (int n = 0; n < 4; ++n) acc[m][n] = (f32x4){0.f, 0.f, 0.f, 0.f};
    const int frag = fr * 64 + ((fq ^ ((fr >> 3) << 1)) << 4);
    const int nk = t.nk;
    for (int kt = 0; kt < nk; ++kt) {
        if (kt + 1 < nk) asm volatile("s_waitcnt vmcnt(6)" ::: "memory");
        else asm volatile("s_waitcnt vmcnt(0)" ::: "memory");
        __syncthreads();
        if (kt + 2 < nk) g2_issue(t, kt + 2, st >= 1 ? st - 1 : 2, smem);
        const char* sa = smem + st * 24576 + frag;
        bf16x8 bfr[4];
#pragma unroll
        for (int n = 0; n < 4; ++n) bfr[n] = *(const bf16x8*)(sa + (16 + wc * 4 + n) * 1024);
#pragma unroll
        for (int mh = 0; mh < 2; ++mh) {
            bf16x8 af[4];
#pragma unroll
            for (int m = 0; m < 4; ++m) af[m] = *(const bf16x8*)(sa + (wr * 8 + mh * 4 + m) * 1024);
            __builtin_amdgcn_s_setprio(1);
#pragma unroll
            for (int m = 0; m < 4; ++m)
#pragma unroll
                for (int n = 0; n < 4; ++n)
                    acc[mh * 4 + m][n] = TRANS ? __builtin_amdgcn_mfma_f32_16x16x32_bf16(bfr[n], af[m], acc[mh * 4 + m][n], 0, 0, 0)
                                               : __builtin_amdgcn_mfma_f32_16x16x32_bf16(af[m], bfr[n], acc[mh * 4 + m][n], 0, 0, 0);
            __builtin_amdgcn_s_setprio(0);
        }
        st = st == 2 ? 0 : st + 1;
    }
    if (has_next) g2_prologue(nxt, st, smem);
    epi.template operator()<8>(acc, t.row0 + wr * 128, t.col0 + wc * 64, fr, fq);
    return st;
}

DEVI uint4 widen16(uint2 x, uint2 y) {
    const auto r0 = __builtin_amdgcn_permlane16_swap(x.x, y.x, false, false);
    const auto r1 = __builtin_amdgcn_permlane16_swap(x.y, y.y, false, false);
    uint4 o; o.x = r0[0]; o.y = r1[0]; o.z = r0[1]; o.w = r1[1];
    return o;
}

struct EpiG0A {
    bf16_t *u, *sg, *sgf;
    template <int MT> DEVI void operator()(f32x4 (&acc)[MT][4], int row0, int col0, int fr, int fq) const {
        const int type = col0 >> 10;
        bf16_t* dst = type == 0 ? u : (type == 1 ? sg : sgf);
        const int cb = (col0 & 1023) + 16 * (fq & 1) + 8 * (fq >> 1);
#pragma unroll
        for (int m = 0; m < MT; ++m) {
            __builtin_amdgcn_sched_barrier(0);
            bf16_t* rp = dst + (size_t)(row0 + 16 * m + fr) * 1024 + cb;
#pragma unroll
            for (int n = 0; n < 4; n += 2) {
                f32x4 v = acc[m][n], w_ = acc[m][n + 1];
                if (type) { v[0] = siluf_(v[0]); v[1] = siluf_(v[1]); v[2] = siluf_(v[2]); v[3] = siluf_(v[3]);
                            w_[0] = siluf_(w_[0]); w_[1] = siluf_(w_[1]); w_[2] = siluf_(w_[2]); w_[3] = siluf_(w_[3]); }
                uint2 x, y; x.x = pk2(v[0], v[1]); x.y = pk2(v[2], v[3]); y.x = pk2(w_[0], w_[1]); y.y = pk2(w_[2], w_[3]);
                *(uint4*)(rp + 16 * n) = widen16(x, y);
            }
        }
    }
};
struct EpiG0B {
    bf16_t *pqt, *pqtc;
    template <int MT> DEVI void operator()(f32x4 (&acc)[MT][4], int row0, int col0, int fr, int fq) const {
        const int isq = col0 >> 10;
        const int b = row0 / TPB, t0 = row0 - b * TPB;
#pragma unroll
        for (int m = 0; m < MT; ++m)
#pragma unroll
            for (int n = 0; n < 4; ++n) {
                const int e = (col0 & 1023) + 16 * n + fr;
                const int t = t0 + 16 * m + 4 * fq;
                f32x4 v = acc[m][n];
                uint2 o; o.x = pk2(v[0], v[1]); o.y = pk2(v[2], v[3]);
                bf16_t* dst = (t < CTX) ? pqtc + ((size_t)(b * 1024 + e)) * 512 + isq * 256 + t
                                        : pqt + ((size_t)(b * 1024 + e)) * 8192 + isq * 4096 + (t - CTX);
                *(uint2*)dst = o;
            }
    }
};
struct EpiDFT {
    bf16_t* sgf; const float* bfv; float scale;
    template <int MT> DEVI void operator()(f32x4 (&acc)[MT][4], int row0, int col0, int fr, int fq) const {
#pragma unroll
        for (int n = 0; n < 4; ++n) {
            const int col = col0 + 16 * n + 4 * fq;
            const f32x4 bb = *(const f32x4*)(bfv + col);
#pragma unroll
            for (int m = 0; m < MT; ++m) {
                bf16_t* ptr = sgf + (size_t)(row0 + 16 * m + fr) * 1024 + col;
                const uint2 s = *(const uint2*)ptr;
                f32x4 v = acc[m][n] * scale + bb;
                uint2 o; o.x = pk2(v[0] * bflo(s.x), v[1] * bfhi(s.x)); o.y = pk2(v[2] * bflo(s.y), v[3] * bfhi(s.y));
                *(uint2*)ptr = o;
            }
        }
    }
};
struct EpiYc {
    float* T; const float* ps1024; int b, par;
    template <int MT> DEVI void operator()(f32x4 (&acc)[MT][4], int row0, int col0, int fr, int fq) const {
#pragma unroll
        for (int n = 0; n < 4; ++n) {
            const int e = col0 + 16 * n + 4 * fq;
            f32x4 pv = *(const f32x4*)(ps1024 + b * 1024 + e);
            if (par) pv = (f32x4){0.f, 0.f, 0.f, 0.f};
#pragma unroll
            for (int m = 0; m < MT; ++m) {
                const int k = row0 + 16 * m + fr;
                const float sg = (k & 1) ? -1.0f : 1.0f;
                *(f32x4*)(T + ((size_t)((b * 2 + par) * 1024 + k)) * 1024 + e) = acc[m][n] + pv * sg;
            }
        }
    }
};
struct EpiYs {
    const float* T; bf16_t* sgf; const float* bfv; float scale; const float* qs1024; int b, par;
    template <int MT> DEVI void operator()(f32x4 (&acc)[MT][4], int row0, int col0, int fr, int fq) const {
        const float sg = (float)(par * (1 - 2 * (fr & 1)));
        f32x4 qt[4];
#pragma unroll
        for (int n = 0; n < 4; ++n) qt[n] = *(const f32x4*)(qs1024 + b * 1024 + col0 + 16 * n + 4 * fq) * sg;
#pragma unroll
        for (int m = 0; m < MT; ++m) {
            __builtin_amdgcn_sched_barrier(0);
            const int kp = row0 + 16 * m + fr, k = 2 * kp + par;
            const float* trow = T + ((size_t)((b * 2 + par) * 1024 + kp)) * 1024 + col0 + 4 * fq;
            bf16_t* p1 = sgf + (size_t)(b * TPB + CTX + k) * 1024 + col0 + 4 * fq;
            bf16_t* p2 = sgf + (size_t)(b * TPB + CTX + 4096 - k) * 1024 + col0 + 4 * fq;
            uint2 o1[4], o2[4];
#pragma unroll
            for (int n = 0; n < 4; ++n) {
                const f32x4 bb = *(const f32x4*)(bfv + col0 + 16 * n + 4 * fq);
                const f32x4 yc = *(const f32x4*)(trow + 16 * n);
                const f32x4 ys = acc[m][n] + qt[n];
                {
                    const uint2 s = *(const uint2*)(p1 + 16 * n);
                    const f32x4 v = (yc - ys) * scale + bb;
                    o1[n].x = pk2(v[0] * bflo(s.x), v[1] * bfhi(s.x)); o1[n].y = pk2(v[2] * bflo(s.y), v[3] * bfhi(s.y));
                }
                o2[n].x = 0u; o2[n].y = 0u;
                if (k >= 1) {
                    const uint2 s = *(const uint2*)(p2 + 16 * n);
                    const f32x4 v = (yc + ys) * scale + bb;
                    o2[n].x = pk2(v[0] * bflo(s.x), v[1] * bfhi(s.x)); o2[n].y = pk2(v[2] * bflo(s.y), v[3] * bfhi(s.y));
                }
            }
            const int wo = 16 * (fq & 1) + 8 * (fq >> 1) - 4 * fq;
#pragma unroll
            for (int n = 0; n < 4; n += 2) {
                const uint4 a1 = widen16(o1[n], o1[n + 1]), a2 = widen16(o2[n], o2[n + 1]);
                *(uint4*)(p1 + wo + 16 * n) = a1;
                if (k >= 1) *(uint4*)(p2 + wo + 16 * n) = a2;
            }
        }
    }
};
struct EpiFoldT {
    bf16_t* dst;
    template <int MT> DEVI void operator()(f32x4 (&acc)[MT][4], int row0, int col0, int fr, int fq) const {
#pragma unroll
        for (int m = 0; m < MT; ++m)
#pragma unroll
            for (int n = 0; n < 4; n += 2) {
                const f32x4 v = acc[m][n], w_ = acc[m][n + 1];
                uint2 x, y; x.x = pk2(v[0], v[1]); x.y = pk2(v[2], v[3]); y.x = pk2(w_[0], w_[1]); y.y = pk2(w_[2], w_[3]);
                *(uint4*)(dst + (size_t)(col0 + 16 * (n + (fq & 1)) + fr) * 1024 + row0 + 16 * m + 8 * (fq >> 1)) = widen16(x, y);
            }
    }
};
struct EpiF32 {
    float* dst;
    template <int MT> DEVI void operator()(f32x4 (&acc)[MT][4], int row0, int col0, int fr, int fq) const {
#pragma unroll
        for (int m = 0; m < MT; ++m) {
            __builtin_amdgcn_sched_barrier(0);
            float* rp = dst + (size_t)(row0 + 16 * m + fr) * 1024 + col0 + 4 * fq;
#pragma unroll
            for (int n = 0; n < 4; ++n) *(f32x4*)(rp + 16 * n) = acc[m][n];
        }
    }
};
struct EpiBf16 {
    bf16_t* dst;
    template <int MT> DEVI void operator()(f32x4 (&acc)[MT][4], int row0, int col0, int fr, int fq) const {
#pragma unroll
        for (int m = 0; m < MT; ++m) {
            __builtin_amdgcn_sched_barrier(0);
            bf16_t* rp = dst + (size_t)(row0 + 16 * m + fr) * 1024 + col0 + 16 * (fq & 1) + 8 * (fq >> 1);
#pragma unroll
            for (int n = 0; n < 4; n += 2) {
                uint2 x, y;
                x.x = pk2(acc[m][n][0], acc[m][n][1]); x.y = pk2(acc[m][n][2], acc[m][n][3]);
                y.x = pk2(acc[m][n + 1][0], acc[m][n + 1][1]); y.y = pk2(acc[m][n + 1][2], acc[m][n + 1][3]);
                *(uint4*)(rp + 16 * n) = widen16(x, y);
            }
        }
    }
};
struct EpiG2A {
    bf16_t *q, *kbuf, *sgate; const float *ropec, *ropes;
    template <int MT> DEVI void operator()(f32x4 (&acc)[MT][4], int row0, int col0, int fr, int fq) const {
        const int b = row0 / TPB, t0 = row0 - b * TPB;
        const bool isctx = t0 < CTX;
        if (col0 < 1280) {
            const bool isq = col0 < 1024;
            if (isq && isctx) return;
#pragma unroll
            for (int m = 0; m < MT; ++m) {
                const int t = t0 + 16 * m + fr;
                f32x4 o0 = acc[m][0], o1 = acc[m][1], o2 = acc[m][2], o3 = acc[m][3];
                if (!isctx) {
                    const int pos = t - CTX, prow = pos >> 6, pcol = pos & 63;
                    const f32x4 cr = *(const f32x4*)(ropec + prow * 16 + 4 * fq), sr = *(const f32x4*)(ropes + prow * 16 + 4 * fq);
                    const f32x4 cc = *(const f32x4*)(ropec + pcol * 16 + 4 * fq), sc = *(const f32x4*)(ropes + pcol * 16 + 4 * fq);
                    const f32x4 a0 = o0 * cr - o1 * sr, a1 = o1 * cr + o0 * sr;
                    const f32x4 a2 = o2 * cc - o3 * sc, a3 = o3 * cc + o2 * sc;
                    o0 = a0; o1 = a1; o2 = a2; o3 = a3;
                }
                bf16_t* dst;
                if (isq) {
                    const float qs = 0.125f * LOG2E;
                    o0 *= qs; o1 *= qs; o2 *= qs; o3 *= qs;
                    dst = q + (size_t)(b * SEQ + t - CTX) * 1024 + col0 + 16 * (fq & 1) + 8 * (fq >> 1);
                } else {
                    dst = kbuf + (size_t)(row0 + 16 * m + fr) * 256 + (col0 - 1024) + 16 * (fq & 1) + 8 * (fq >> 1);
                }
                uint2 x, y;
                x.x = pk2(o0[0], o0[1]); x.y = pk2(o0[2], o0[3]); y.x = pk2(o1[0], o1[1]); y.y = pk2(o1[2], o1[3]);
                *(uint4*)(dst) = widen16(x, y);
                x.x = pk2(o2[0], o2[1]); x.y = pk2(o2[2], o2[3]); y.x = pk2(o3[0], o3[1]); y.y = pk2(o3[2], o3[3]);
                *(uint4*)(dst + 32) = widen16(x, y);
            }
        } else {
            if (isctx) return;
#pragma unroll
            for (int m = 0; m < MT; ++m)
#pragma unroll
                for (int n = 0; n < 4; n += 2) {
                    const f32x4 v = acc[m][n], w_ = acc[m][n + 1];
                    uint2 x, y;
                    x.x = pk2(siluf_(v[0]), siluf_(v[1])); x.y = pk2(siluf_(v[2]), siluf_(v[3]));
                    y.x = pk2(siluf_(w_[0]), siluf_(w_[1])); y.y = pk2(siluf_(w_[2]), siluf_(w_[3]));
                    *(uint4*)(sgate + (size_t)(b * SEQ + t0 - CTX + 16 * m + fr) * 1024 + (col0 - 1280) + 16 * n + 16 * (fq & 1) + 8 * (fq >> 1)) = widen16(x, y);
                }
        }
    }
};
struct EpiG2B {
    bf16_t* vt;
    template <int MT> DEVI void operator()(f32x4 (&acc)[MT][4], int row0, int col0, int fr, int fq) const {
        const int b = row0 / TPB, t0 = row0 - b * TPB;
#pragma unroll
        for (int m = 0; m < MT; ++m)
#pragma unroll
            for (int n = 0; n < 4; ++n) {
                f32x4 v = acc[m][n];
                uint2 o; o.x = pk2(v[0], v[1]); o.y = pk2(v[2], v[3]);
                *(uint2*)(vt + ((size_t)(b * 256 + col0 + 16 * n + fr)) * TPB + t0 + 16 * m + 4 * fq) = o;
            }
    }
};

DEVI void transpose64(const float* __restrict__ src, int ld_src, bf16_t* __restrict__ dst, int ld_dst, float* sm) {
    const int tid = threadIdx.x;
    __syncthreads();
#pragma unroll
    for (int i = 0; i < 4; ++i) {
        const int k = (tid >> 4) + 16 * i, c4 = (tid & 15) * 4;
        const float4 v = *(const float4*)(src + (size_t)k * ld_src + c4);
        sm[(c4 + 0) * 65 + k] = v.x; sm[(c4 + 1) * 65 + k] = v.y; sm[(c4 + 2) * 65 + k] = v.z; sm[(c4 + 3) * 65 + k] = v.w;
    }
    __syncthreads();
#pragma unroll
    for (int i = 0; i < 2; ++i) {
        const int n = (tid >> 3) + 32 * i, k0 = (tid & 7) * 8;
        const float* s = sm + n * 65 + k0;
        uint4 o; o.x = pk2(s[0], s[1]); o.y = pk2(s[2], s[3]); o.z = pk2(s[4], s[5]); o.w = pk2(s[6], s[7]);
        *(uint4*)(dst + (size_t)n * ld_dst + k0) = o;
    }
}

DEVI void transpose_job(const P& p, int id, float* sm) {
    char* ws = p.ws;
    bf16_t* W0T = (bf16_t*)(ws + OFF_W0T); bf16_t* WO0T = (bf16_t*)(ws + OFF_WO0T);
    bf16_t* W1T = (bf16_t*)(ws + OFF_W1T); bf16_t* WO1T = (bf16_t*)(ws + OFF_WO1T); bf16_t* WG = (bf16_t*)(ws + OFF_WG);
    const float* src; int ld_src, col0, nct; bf16_t* dst; int ld_dst, drow0;
    if (id < 256) { src = p.w_in0; ld_src = 4096; col0 = 0; nct = 16; dst = W0T; ld_dst = 1024; drow0 = 0; }
    else if (id < 512) { id -= 256; src = p.w_in0; ld_src = 4096; col0 = 1024; nct = 16; dst = W0T; ld_dst = 1024; drow0 = 1024; }
    else if (id < 768) { id -= 512; src = p.w_in0; ld_src = 4096; col0 = 3072; nct = 16; dst = W0T; ld_dst = 1024; drow0 = 2048; }
    else if (id < 1280) { id -= 768; src = p.w_out0; ld_src = 1024; col0 = 0; nct = 16; dst = WO0T; ld_dst = 2048; drow0 = 0; }
    else if (id < 1536) { id -= 1280; src = p.w_in1; ld_src = 2560; col0 = 0; nct = 16; dst = W1T; ld_dst = 1024; drow0 = 0; }
    else if (id < 1600) { id -= 1536; src = p.w_in1; ld_src = 2560; col0 = 1024; nct = 4; dst = W1T; ld_dst = 1024; drow0 = 1024; }
    else if (id < 1856) { id -= 1600; src = p.w_in1; ld_src = 2560; col0 = 1536; nct = 16; dst = W1T; ld_dst = 1024; drow0 = 1280; }
    else if (id < 1920) { id -= 1856; src = p.w_in1; ld_src = 2560; col0 = 1280; nct = 4; dst = W1T; ld_dst = 1024; drow0 = 2304; }
    else if (id < 2176) { id -= 1920; src = p.w_out1; ld_src = 1024; col0 = 0; nct = 16; dst = WO1T; ld_dst = 1024; drow0 = 0; }
    else {
        id -= 2176;
        const int h = id & 15, ax = (id >> 4) & 1, dir = id >> 5;
        src = (ax ? p.w_x : p.w_a) + (size_t)(dir * 16 + h) * 4096;
        transpose64(src, 64, WG + (size_t)(h * 256 + (dir * 2 + ax) * 64) * 64, 64, sm);
        return;
    }
    const int kt = id / nct, nt = id % nct;
    transpose64(src + (size_t)(kt * 64) * ld_src + col0 + nt * 64, ld_src, dst + (size_t)(drow0 + nt * 64) * ld_dst + kt * 64, ld_dst, sm);
}

DEVI void mods_item(const P& p, int it, float* sm) {
    const int tid = threadIdx.x;
    const int layer = it / 192, col0 = (it % 192) * 16;
    const float* wmod = layer ? p.w_mod1 : p.w_mod0;
    const float* bmod = layer ? p.b_mod1 : p.b_mod0;
    float* sc = sm;
    float* red = sm + 9216;
    __syncthreads();
    for (int i = tid; i < 9216; i += 256) {
        const int r = i >> 10, k = i & 1023;
        const float v = r < 8 ? p.c[r * 1024 + k] : p.c_ctx[k];
        sc[i] = siluf_(v);
    }
    __syncthreads();
    const int col = tid & 15, kg = tid >> 4;
    float acc[9];
#pragma unroll
    for (int r = 0; r < 9; ++r) acc[r] = 0.f;
#pragma unroll
    for (int k0 = 0; k0 < 64; k0 += 32) {
        float wv[32];
#pragma unroll
        for (int u = 0; u < 32; ++u) wv[u] = wmod[(size_t)(kg * 64 + k0 + u) * 3072 + col0 + col];
#pragma unroll
        for (int u = 0; u < 32; ++u)
#pragma unroll
            for (int r = 0; r < 9; ++r) acc[r] += sc[r * 1024 + kg * 64 + k0 + u] * wv[u];
    }
#pragma unroll
    for (int r = 0; r < 9; ++r) red[(kg * 9 + r) * 16 + col] = acc[r];
    __syncthreads();
    float* mods = (float*)(p.ws + OFF_MODS);
    if (tid < 144) {
        const int r = tid >> 4, cc = tid & 15;
        float v = bmod[col0 + cc];
#pragma unroll
        for (int g = 0; g < 16; ++g) v += red[(g * 9 + r) * 16 + cc];
        mods[(size_t)(layer * 9 + r) * 3072 + col0 + cc] = v;
    }
}

DEVI void dft_row_item(const P& p, int k) {
    const int tid = threadIdx.x;
    if (k < 1024) {
        bf16_t* base = (bf16_t*)(p.ws + OFF_DL) + (size_t)k * 1024;
        const int n0 = tid * 4;
        float ce[4], co[4], se[4], so[4];
#pragma unroll
        for (int e = 0; e < 4; ++e) {
            const int n = n0 + e;
            const float fe = (float)((k * n) & 2047) * (1.0f / 2048.0f);
            const float fo = (float)(((2 * k + 1) * n) & 4095) * (1.0f / 4096.0f);
            ce[e] = __builtin_amdgcn_cosf(fe); se[e] = __builtin_amdgcn_sinf(fe);
            co[e] = __builtin_amdgcn_cosf(fo); so[e] = __builtin_amdgcn_sinf(fo);
        }
        uint2 o;
        o.x = pk2(ce[0], ce[1]); o.y = pk2(ce[2], ce[3]); *(uint2*)(base + n0) = o;
        o.x = pk2(co[0], co[1]); o.y = pk2(co[2], co[3]); *(uint2*)(base + 1048576 + n0) = o;
        o.x = pk2(se[0], se[1]); o.y = pk2(se[2], se[3]); *(uint2*)(base + 2 * 1048576 + n0) = o;
        o.x = pk2(so[0], so[1]); o.y = pk2(so[2], so[3]); *(uint2*)(base + 3 * 1048576 + n0) = o;
    } else {
        const int kk = k - 1024;
        bf16_t* dc = (bf16_t*)(p.ws + OFF_DC) + (size_t)kk * 512;
        if (tid < 64) {
            const int n0 = tid * 8;
            float v[8];
#pragma unroll
            for (int e = 0; e < 8; ++e) {
                const int ci = n0 + e, n = ci & 255;
                const float fr_ = (float)((kk * n) & 255) * (1.0f / 256.0f);
                v[e] = ci < 256 ? __builtin_amdgcn_cosf(fr_) : -__builtin_amdgcn_sinf(fr_);
            }
            uint4 o; o.x = pk2(v[0], v[1]); o.y = pk2(v[2], v[3]); o.z = pk2(v[4], v[5]); o.w = pk2(v[6], v[7]);
            *(uint4*)(dc + n0) = o;
        }
    }
}

DEVI void wcs_item(const P& p, int it) {
    const int tid = threadIdx.x;
    const int g = it >> 6, d = (it & 63) * 2 + (tid >> 7), e = tid & 127;
    float ac = 0.f, as = 0.f;
#pragma unroll 1
    for (int l0 = 0; l0 < 128; l0 += 32) {
        float wv[32];
#pragma unroll
        for (int u = 0; u < 32; ++u) wv[u] = p.w_f[(size_t)(g * 128 + l0 + u) * 128 + e];
#pragma unroll
        for (int u = 0; u < 32; ++u) {
            const float fr_ = (float)(((l0 + u) * d) & 127) * (1.0f / 128.0f);
            ac += __builtin_amdgcn_cosf(fr_) * wv[u];
            as += __builtin_amdgcn_sinf(fr_) * wv[u];
        }
    }
    float* wc = (float*)(p.ws + OFF_WCS);
    wc[(size_t)(g * 128 + d) * 128 + e] = ac;
    wc[131072 + (size_t)(g * 128 + d) * 128 + e] = as;
}

DEVI void rope_item(const P& p) {
    float* rc = (float*)(p.ws + OFF_ROPE);
    for (int i = threadIdx.x; i < 1024; i += 256) {
        const int pos = i >> 4, j = i & 15;
        const float freq = powf(10000.0f, -(float)(2 * j) / 32.0f);
        const float ang = (float)pos * freq;
        rc[i] = cosf(ang);
        rc[1024 + i] = sinf(ang);
    }
}

DEVI void compose_item(const P& p, int it, float* sm) {
    const int tid = threadIdx.x;
    const int g = it >> 5, j0 = (it & 31) * 32;
    __syncthreads();
#pragma unroll
    for (int i = 0; i < 4; ++i) {
        const int row = (tid >> 5) + 8 * i, c4 = (tid & 31) * 4;
        *(float4*)(sm + row * 128 + c4) = *(const float4*)(p.w_in0 + (size_t)(j0 + row) * 4096 + 2048 + 128 * g + c4);
    }
    __syncthreads();
    const int e = tid & 127, half = tid >> 7;
    const float* wc = (const float*)(p.ws + OFF_WCS) + (size_t)g * 16384 + e;
    const float* wsn = wc + 131072;
    float ap[16], aq[16];
#pragma unroll
    for (int jj = 0; jj < 16; ++jj) { ap[jj] = 0.f; aq[jj] = 0.f; }
#pragma unroll 1
    for (int d0 = 0; d0 < 128; d0 += 16) {
        float cw[16], sw[16];
#pragma unroll
        for (int u = 0; u < 16; ++u) { cw[u] = wc[(d0 + u) * 128]; sw[u] = wsn[(d0 + u) * 128]; }
#pragma unroll
        for (int jj = 0; jj < 16; ++jj) {
#pragma unroll
            for (int u = 0; u < 16; u += 4) {
                const f32x4 v = *(const f32x4*)(sm + (half * 16 + jj) * 128 + d0 + u);
                ap[jj] += v[0] * cw[u] + v[1] * cw[u + 1] + v[2] * cw[u + 2] + v[3] * cw[u + 3];
                aq[jj] += v[0] * sw[u] + v[1] * sw[u + 1] + v[2] * sw[u + 2] + v[3] * sw[u + 3];
            }
        }
    }
    bf16_t* W0T = (bf16_t*)(p.ws + OFF_W0T);
    bf16_t* dp = W0T + (size_t)(3072 + g * 128 + e) * 1024 + j0 + half * 16;
    bf16_t* dq = W0T + (size_t)(4096 + g * 128 + e) * 1024 + j0 + half * 16;
    uint4 o;
    o.x = pk2(ap[0], ap[1]); o.y = pk2(ap[2], ap[3]); o.z = pk2(ap[4], ap[5]); o.w = pk2(ap[6], ap[7]); *(uint4*)dp = o;
    o.x = pk2(ap[8], ap[9]); o.y = pk2(ap[10], ap[11]); o.z = pk2(ap[12], ap[13]); o.w = pk2(ap[14], ap[15]); *(uint4*)(dp + 8) = o;
    o.x = pk2(aq[0], aq[1]); o.y = pk2(aq[2], aq[3]); o.z = pk2(aq[4], aq[5]); o.w = pk2(aq[6], aq[7]); *(uint4*)dq = o;
    o.x = pk2(aq[8], aq[9]); o.y = pk2(aq[10], aq[11]); o.z = pk2(aq[12], aq[13]); o.w = pk2(aq[14], aq[15]); *(uint4*)(dq + 8) = o;
}

DEVI float sumsq4(const f32x4& v) { return v[0] * v[0] + v[1] * v[1] + v[2] * v[2] + v[3] * v[3]; }
DEVI void h0_rows(const P& p, int it) {
    const int lane = threadIdx.x & 63, w = threadIdx.x >> 6;
    int r[2], b[2], t[2]; const float* src[2]; const float* mod[2];
#pragma unroll
    for (int q = 0; q < 2; ++q) {
        r[q] = it * 8 + w + 4 * q; b[q] = r[q] / TPB; t[q] = r[q] - b[q] * TPB;
        src[q] = t[q] < CTX ? p.ctx + (size_t)(b[q] * CTX + t[q]) * 1024 : p.x + (size_t)(b[q] * SEQ + t[q] - CTX) * 1024;
        mod[q] = (const float*)(p.ws + OFF_MODS) + (size_t)(t[q] < CTX ? 8 : b[q]) * 3072;
    }
    f32x4 v[2][4];
    float ss[2] = {0.f, 0.f};
#pragma unroll
    for (int q = 0; q < 2; ++q)
#pragma unroll
        for (int i = 0; i < 4; ++i) v[q][i] = *(const f32x4*)(src[q] + (i * 64 + lane) * 4);
#pragma unroll
    for (int q = 0; q < 2; ++q) {
#pragma unroll
        for (int i = 0; i < 4; ++i) ss[q] += sumsq4(v[q][i]);
        ss[q] = wave_sum(ss[q]);
    }
#pragma unroll
    for (int q = 0; q < 2; ++q) {
        const float rstd = rsqrtf(ss[q] * (1.0f / 1024.0f) + 1e-6f);
        bf16_t* hb = (bf16_t*)(p.ws + OFF_A) + (size_t)r[q] * 1024;
#pragma unroll
        for (int i = 0; i < 4; ++i) {
            const int col = (i * 64 + lane) * 4;
            const f32x4 g = *(const f32x4*)(p.g_pre0 + col), sh = *(const f32x4*)(mod[q] + col), sc = *(const f32x4*)(mod[q] + 1024 + col);
            const f32x4 h = (v[q][i] * rstd * g) * (sc + 1.0f) + sh;
            uint2 o; o.x = pk2(h[0], h[1]); o.y = pk2(h[2], h[3]);
            *(uint2*)(hb + col) = o;
        }
    }
}

DEVI void norm1_rows(const P& p, int it) {
    const int lane = threadIdx.x & 63, w = threadIdx.x >> 6;
    int r[2], b[2], t[2]; const float* src[2]; const float* mod0[2];
#pragma unroll
    for (int q = 0; q < 2; ++q) {
        r[q] = it * 8 + w + 4 * q; b[q] = r[q] / TPB; t[q] = r[q] - b[q] * TPB;
        src[q] = t[q] < CTX ? p.ctx + (size_t)(b[q] * CTX + t[q]) * 1024 : p.x + (size_t)(b[q] * SEQ + t[q] - CTX) * 1024;
        mod0[q] = (const float*)(p.ws + OFF_MODS) + (size_t)(t[q] < CTX ? 8 : b[q]) * 3072;
    }
    f32x4 v[2][4], xs[2][4];
    float ss[2] = {0.f, 0.f};
#pragma unroll
    for (int q = 0; q < 2; ++q) {
        const bf16_t* y = (const bf16_t*)(p.ws + OFF_E) + (size_t)r[q] * 1024;
#pragma unroll
        for (int i = 0; i < 4; ++i) {
            const uint2 q_ = *(const uint2*)(y + (i * 64 + lane) * 4);
            v[q][i] = (f32x4){bflo(q_.x), bfhi(q_.x), bflo(q_.y), bfhi(q_.y)};
            xs[q][i] = *(const f32x4*)(src[q] + (i * 64 + lane) * 4);
        }
    }
#pragma unroll
    for (int q = 0; q < 2; ++q) {
#pragma unroll
        for (int i = 0; i < 4; ++i) ss[q] += sumsq4(v[q][i]);
        ss[q] = wave_sum(ss[q]);
    }
    float ss2[2] = {0.f, 0.f};
#pragma unroll
    for (int q = 0; q < 2; ++q) {
        const float rstd = rsqrtf(ss[q] * (1.0f / 1024.0f) + 1e-6f);
#pragma unroll
        for (int i = 0; i < 4; ++i) {
            const int col = (i * 64 + lane) * 4;
            const f32x4 g = *(const f32x4*)(p.g_post0 + col), gt = *(const f32x4*)(mod0[q] + 2048 + col);
            v[q][i] = xs[q][i] + gt * (v[q][i] * rstd * g);
            ss2[q] += sumsq4(v[q][i]);
            if (t[q] >= CTX) *(f32x4*)(p.out + (size_t)(b[q] * SEQ + t[q] - CTX) * 1024 + col) = v[q][i];
        }
        ss2[q] = wave_sum(ss2[q]);
    }
#pragma unroll
    for (int q = 0; q < 2; ++q) {
        const float rstd2 = rsqrtf(ss2[q] * (1.0f / 1024.0f) + 1e-6f);
        const float* mod1 = mod0[q] + 9 * 3072;
        bf16_t* hb = (bf16_t*)(p.ws + OFF_A) + (size_t)r[q] * 1024;
#pragma unroll
        for (int i = 0; i < 4; ++i) {
            const int col = (i * 64 + lane) * 4;
            const f32x4 g = *(const f32x4*)(p.g_pre1 + col), sh = *(const f32x4*)(mod1 + col), sc = *(const f32x4*)(mod1 + 1024 + col);
            const f32x4 h = (v[q][i] * rstd2 * g) * (sc + 1.0f) + sh;
            uint2 o; o.x = pk2(h[0], h[1]); o.y = pk2(h[2], h[3]);
            *(uint2*)(hb + col) = o;
        }
    }
}

DEVI void final_rows(const P& p, int it) {
    const int lane = threadIdx.x & 63, w = threadIdx.x >> 6;
    f32x4 v[2][4], xs[2][4];
    float ss[2] = {0.f, 0.f};
#pragma unroll
    for (int q = 0; q < 2; ++q) {
        const int r = it * 8 + w + 4 * q;
        const bf16_t* y = (const bf16_t*)(p.ws + OFF_E) + (size_t)r * 1024;
        const float* o = p.out + (size_t)r * 1024;
#pragma unroll
        for (int i = 0; i < 4; ++i) {
            const uint2 q_ = *(const uint2*)(y + (i * 64 + lane) * 4);
            v[q][i] = (f32x4){bflo(q_.x), bfhi(q_.x), bflo(q_.y), bfhi(q_.y)};
            xs[q][i] = *(const f32x4*)(o + (i * 64 + lane) * 4);
        }
    }
#pragma unroll
    for (int q = 0; q < 2; ++q) {
#pragma unroll
        for (int i = 0; i < 4; ++i) ss[q] += sumsq4(v[q][i]);
        ss[q] = wave_sum(ss[q]);
    }
#pragma unroll
    for (int q = 0; q < 2; ++q) {
        const int r = it * 8 + w + 4 * q, b = r >> 12;
        const float* mod1 = (const float*)(p.ws + OFF_MODS) + (size_t)(9 + b) * 3072;
        float* o = p.out + (size_t)r * 1024;
        const float rstd = rsqrtf(ss[q] * (1.0f / 1024.0f) + 1e-6f);
#pragma unroll
        for (int i = 0; i < 4; ++i) {
            const int col = (i * 64 + lane) * 4;
            const f32x4 g = *(const f32x4*)(p.g_post1 + col), gt = *(const f32x4*)(mod1 + 2048 + col);
            *(f32x4*)(o + col) = xs[q][i] + gt * (v[q][i] * rstd * g);
        }
    }
}

constexpr size_t OFF_PS1024 = 510 * MiB;
constexpr size_t OFF_QS1024 = 510 * MiB + 64 * 1024;
constexpr size_t OFF_HPART = 510 * MiB + 256 * 1024;
constexpr size_t OFF_HS = 510 * MiB + 1024 * 1024;
constexpr size_t OFF_HF = OFF_E;
constexpr size_t OFF_T = OFF_E;
constexpr size_t OFF_PE = OFF_E + 64 * MiB;
DEVI float bfe(const uint4& q, int i) { const unsigned wd = (i >> 1) == 0 ? q.x : ((i >> 1) == 1 ? q.y : ((i >> 1) == 2 ? q.z : q.w)); return (i & 1) ? bfhi(wd) : bflo(wd); }
DEVI void hfold_item(const P& p, int it, float* sm) {
    const int tid = threadIdx.x, lane = tid & 63, w = tid >> 6;
    const int b = it >> 4, nb = it & 15;
    const bf16_t* H = (const bf16_t*)(p.ws + OFF_A) + (size_t)(b * TPB + CTX) * 1024;
    bf16_t* HF = (bf16_t*)(p.ws + OFF_HF) + (size_t)b * 4 * 1048576;
    float alt[16];
#pragma unroll
    for (int c = 0; c < 16; ++c) alt[c] = 0.f;
    for (int k = 0; k < 16; ++k) {
        const int n = nb * 64 + w * 16 + k;
        const float sgn = (n & 1) ? -1.0f : 1.0f;
        const int nB = n == 0 ? 0 : 4096 - n;
#pragma unroll
        for (int i = 0; i < 2; ++i) {
            const int j0 = (i * 64 + lane) * 8;
            const uint4 qa = *(const uint4*)(H + (size_t)n * 1024 + j0), qb = *(const uint4*)(H + (size_t)nB * 1024 + j0);
            const uint4 qc = *(const uint4*)(H + (size_t)(2048 - n) * 1024 + j0), qd = *(const uint4*)(H + (size_t)(2048 + n) * 1024 + j0);
            float he[8], ho[8], hqe[8], hqo[8];
#pragma unroll
            for (int c = 0; c < 8; ++c) {
                const float A = bfe(qa, c), C = bfe(qc, c);
                const float B = n == 0 ? 0.f : bfe(qb, c), D = n == 0 ? 0.f : bfe(qd, c);
                he[c] = (A + B) + (C + D); ho[c] = (A + B) - (C + D);
                hqe[c] = n == 0 ? 0.f : (A - B) - (C - D); hqo[c] = n == 0 ? 0.f : (A - B) + (C - D);
                alt[i * 8 + c] += sgn * he[c];
            }
            uint4 o;
            o.x = pk2(he[0], he[1]); o.y = pk2(he[2], he[3]); o.z = pk2(he[4], he[5]); o.w = pk2(he[6], he[7]);
            *(uint4*)(HF + (size_t)n * 1024 + j0) = o;
            o.x = pk2(ho[0], ho[1]); o.y = pk2(ho[2], ho[3]); o.z = pk2(ho[4], ho[5]); o.w = pk2(ho[6], ho[7]);
            *(uint4*)(HF + 1048576 + (size_t)n * 1024 + j0) = o;
            o.x = pk2(hqe[0], hqe[1]); o.y = pk2(hqe[2], hqe[3]); o.z = pk2(hqe[4], hqe[5]); o.w = pk2(hqe[6], hqe[7]);
            *(uint4*)(HF + 2 * 1048576 + (size_t)n * 1024 + j0) = o;
            o.x = pk2(hqo[0], hqo[1]); o.y = pk2(hqo[2], hqo[3]); o.z = pk2(hqo[4], hqo[5]); o.w = pk2(hqo[6], hqo[7]);
            *(uint4*)(HF + 3 * 1048576 + (size_t)n * 1024 + j0) = o;
        }
    }
    __syncthreads();
#pragma unroll
    for (int i = 0; i < 2; ++i)
#pragma unroll
        for (int c = 0; c < 8; ++c) sm[w * 1024 + (i * 64 + lane) * 8 + c] = alt[i * 8 + c];
    __syncthreads();
    float* hp = (float*)(p.ws + OFF_HPART) + (size_t)it * 1024;
#pragma unroll
    for (int c = 0; c < 4; ++c) { const int j = tid * 4 + c; hp[j] = sm[j] + sm[1024 + j] + sm[2048 + j] + sm[3072 + j]; }
    if (nb == 0) {
        float* hs = (float*)(p.ws + OFF_HS) + (size_t)b * 2048;
#pragma unroll
        for (int c = 0; c < 4; ++c) {
            const int j = tid * 4 + c;
            const float h1 = bf2f(H[(size_t)1024 * 1024 + j]), h3 = bf2f(H[(size_t)3072 * 1024 + j]);
            hs[j] = h1 + h3; hs[1024 + j] = h1 - h3;
        }
    }
}

DEVI void fspecial_item(const P& p, int it, float* sm) {
    const int tid = threadIdx.x;
    const int b = it >> 6, e0 = (it & 63) * 16;
    const float* hs = (const float*)(p.ws + OFF_HS) + (size_t)b * 2048;
    const float* part = (const float*)(p.ws + OFF_HPART) + (size_t)b * 16 * 1024;
    __syncthreads();
#pragma unroll
    for (int c = 0; c < 4; ++c) {
        const int j = tid * 4 + c;
        const float hpv = hs[j], hqv = hs[1024 + j];
        float a = hpv;
#pragma unroll
        for (int q = 0; q < 16; ++q) a += part[q * 1024 + j];
        sm[j] = a; sm[1024 + j] = hpv; sm[2048 + j] = hqv;
    }
    __syncthreads();
    const int e = e0 + (tid >> 4), jp = tid & 15;
    const bf16_t* wp = (const bf16_t*)(p.ws + OFF_W0T) + (size_t)(3072 + e) * 1024 + jp * 64;
    const bf16_t* wq = (const bf16_t*)(p.ws + OFF_W0T) + (size_t)(4096 + e) * 1024 + jp * 64;
    float y = 0.f, ps = 0.f, qs = 0.f;
#pragma unroll
    for (int v8 = 0; v8 < 8; ++v8) {
        const uint4 a = *(const uint4*)(wp + v8 * 8), q = *(const uint4*)(wq + v8 * 8);
#pragma unroll
        for (int c = 0; c < 8; ++c) {
            const int j = jp * 64 + v8 * 8 + c;
            const float wa = bfe(a, c), wb = bfe(q, c);
            y += sm[j] * wa; ps += sm[1024 + j] * wa; qs += sm[2048 + j] * wb;
        }
    }
#pragma unroll
    for (int o = 8; o > 0; o >>= 1) { y += __shfl_xor(y, o); ps += __shfl_xor(ps, o); qs += __shfl_xor(qs, o); }
    if (jp == 0) {
        ((float*)(p.ws + OFF_PS1024))[b * 1024 + e] = ps;
        ((float*)(p.ws + OFF_QS1024))[b * 1024 + e] = qs;
        bf16_t* ptr = (bf16_t*)(p.ws + OFF_D) + (size_t)(b * TPB + CTX + 2048) * 1024 + e;
        const float v = (y * 0.0013810679320049757f + p.b_f[e]) * bf2f(*ptr);
        *ptr = (bf16_t)(pk2(v, 0.f) & 0xffffu);
    }
}

constexpr size_t OFF_CIN = OFF_AGG + 9 * MiB;
DEVI void lru_preload(const P& p, int h, char* smem) {
    const int tid = threadIdx.x;
    const bf16_t* WG = (const bf16_t*)(p.ws + OFF_WG) + (size_t)h * 256 * 64;
    float* prm = (float*)(smem + 32768);
    __syncthreads();
#pragma unroll
    for (int i = 0; i < 8; ++i) {
        const int row = (tid >> 3) + 32 * i, ch = tid & 7;
        *(uint4*)(smem + row * 128 + ((ch ^ (row & 7)) << 4)) = *(const uint4*)(WG + (size_t)row * 64 + ch * 8);
    }
    if (tid < 64) {
        const int gch = h * 64 + tid;
#pragma unroll
        for (int k = 0; k < 4; ++k) prm[k * 64 + tid] = p.w_conv[k * 1024 + gch];
        prm[4 * 64 + tid] = p.b_conv[gch];
#pragma unroll
        for (int d = 0; d < 2; ++d) {
            prm[(5 + d) * 64 + tid] = -LOG2E * p.b_a[d * 1024 + gch];
            prm[(7 + d) * 64 + tid] = -LOG2E * p.b_x[d * 1024 + gch];
            const float lm = p.lam[d * 1024 + gch];
            prm[(9 + d) * 64 + tid] = -8.0f * LOG2E * (fmaxf(-lm, 0.f) + log1pf(__expf(-fabsf(lm))));
        }
    }
    __syncthreads();
}

DEVI void lru_load_us(const P& p, int item, int tid, uint4& u0, uint4& u1, uint4& u2) {
    const int h = item & 15, c = (item >> 4) % NCH, b = item / (16 * NCH);
    const int tb = c * 64, seg_lo = c < 4 ? 0 : CTX, seg_hi = c < 4 ? CTX : TPB;
    const bf16_t* U = (const bf16_t*)(p.ws + OFF_B) + (size_t)b * TPB * 1024 + h * 64 + (tid & 7) * 8;
    const uint4 z = {0u, 0u, 0u, 0u};
    const int t0 = tb - 2 + (tid >> 3), t1 = t0 + 32, t2 = t0 + 64;
    u0 = (t0 >= seg_lo && t0 < seg_hi) ? *(const uint4*)(U + (size_t)t0 * 1024) : z;
    u1 = (t1 >= seg_lo && t1 < seg_hi) ? *(const uint4*)(U + (size_t)t1 * 1024) : z;
    u2 = (tid < 24 && t2 >= seg_lo && t2 < seg_hi) ? *(const uint4*)(U + (size_t)t2 * 1024) : z;
}
template <bool PASS_C>
DEVI void lru_item(const P& p, int item, int next_item, uint4& u0, uint4& u1, uint4& u2, float& cpre, char* smem) {
    const int tid = threadIdx.x, lane = tid & 63, w = tid >> 6, fr = lane & 15, fq = lane >> 4;
    const int h = item & 15, c = (item >> 4) % NCH, b = item / (16 * NCH);
    const float* prm = (const float*)(smem + 32768);
    bf16_t* us = (bf16_t*)(smem + 35840);
    char* ucb = smem + 35840 + 8704;
    float* ytile = (float*)(smem + 35840);
    float* wagg = (float*)(smem + 52736);
    float* carry = (float*)(smem + 56832);
    float2* agg = (float2*)(p.ws + OFF_AGG);
    const int tb = c * 64;
    const size_t rbase = (size_t)b * TPB;
    __syncthreads();
    *(uint4*)(us + tid * 8) = u0;
    *(uint4*)(us + (tid + 256) * 8) = u1;
    if (tid < 24) *(uint4*)(us + (tid + 512) * 8) = u2;
    if (PASS_C && tid < 128) carry[tid] = cpre;
    uint4 sg0 = {0u, 0u, 0u, 0u}, sg1 = {0u, 0u, 0u, 0u};
    if (PASS_C) {
        const bf16_t* SG = (const bf16_t*)(p.ws + OFF_C) + (rbase + tb + (tid >> 2)) * 1024 + h * 64 + (tid & 3) * 16;
        sg0 = *(const uint4*)(SG); sg1 = *(const uint4*)(SG + 8);
    }
    if (next_item >= 0) {
        lru_load_us(p, next_item, tid, u0, u1, u2);
        if (PASS_C && tid < 128) {
            const int nh = next_item & 15, nc = (next_item >> 4) % NCH, nb = next_item / (16 * NCH);
            cpre = ((const float*)(p.ws + OFF_CIN))[(size_t)(nb * NCH + nc) * 2048 + (tid >> 6) * 1024 + nh * 64 + (tid & 63)];
        }
    }
    __syncthreads();
    {
        const int tok = tid >> 2, cg0 = (tid & 3) * 16;
        uint4 r[4][2];
#pragma unroll
        for (int k = 0; k < 4; ++k) { r[k][0] = *(const uint4*)(us + (tok + k) * 64 + cg0); r[k][1] = *(const uint4*)(us + (tok + k) * 64 + cg0 + 8); }
        float val[16];
#pragma unroll
        for (int e = 0; e < 16; ++e) {
            const int ch = cg0 + e;
            float a = prm[4 * 64 + ch];
#pragma unroll
            for (int k = 0; k < 4; ++k) {
                const uint4 q = r[k][e >> 3];
                const unsigned wd = ((e >> 1) & 3) == 0 ? q.x : (((e >> 1) & 3) == 1 ? q.y : (((e >> 1) & 3) == 2 ? q.z : q.w));
                a += prm[k * 64 + ch] * ((e & 1) ? bfhi(wd) : bflo(wd));
            }
            val[e] = a;
        }
        uint4 o;
        o.x = pk2(val[0], val[1]); o.y = pk2(val[2], val[3]); o.z = pk2(val[4], val[5]); o.w = pk2(val[6], val[7]);
        *(uint4*)(ucb + tok * 128 + ((((cg0 >> 3) + 0) ^ (tok & 7)) << 4)) = o;
        o.x = pk2(val[8], val[9]); o.y = pk2(val[10], val[11]); o.z = pk2(val[12], val[13]); o.w = pk2(val[14], val[15]);
        *(uint4*)(ucb + tok * 128 + ((((cg0 >> 3) + 1) ^ (tok & 7)) << 4)) = o;
    }
    __syncthreads();
    f32x4 acc[16];
#pragma unroll
    for (int n = 0; n < 16; ++n) acc[n] = (f32x4){0.f, 0.f, 0.f, 0.f};
    {
        bf16x8 af[2];
#pragma unroll
        for (int kk = 0; kk < 2; ++kk) af[kk] = *(const bf16x8*)(ucb + (16 * w + fr) * 128 + (((kk * 4 + fq) ^ (fr & 7)) << 4));
#pragma unroll
        for (int n = 0; n < 16; ++n)
#pragma unroll
            for (int kk = 0; kk < 2; ++kk) {
                const bf16x8 bfr = *(const bf16x8*)(smem + (16 * n + fr) * 128 + (((kk * 4 + fq) ^ (fr & 7)) << 4));
                acc[n] = __builtin_amdgcn_mfma_f32_16x16x32_bf16(af[kk], bfr, acc[n], 0, 0, 0);
            }
    }
    float av[4][2][4], bv[4][2][4], apre[4][2], bpre[4][2];
#pragma unroll
    for (int nn = 0; nn < 4; ++nn) {
        const int ch = 16 * nn + fr;
        float uc[4];
#pragma unroll
        for (int j = 0; j < 4; ++j) {
            const int tl = 16 * w + 4 * fq + j;
            uc[j] = bf2f(*(const bf16_t*)(ucb + tl * 128 + ((((ch >> 3)) ^ (tl & 7)) << 4) + (ch & 7) * 2));
        }
#pragma unroll
        for (int d = 0; d < 2; ++d) {
            const float ba = prm[(5 + d) * 64 + ch], bx = prm[(7 + d) * 64 + ch], nsp8 = prm[(9 + d) * 64 + ch];
#pragma unroll
            for (int j = 0; j < 4; ++j) {
                const float r = __builtin_amdgcn_rcpf(1.0f + __builtin_amdgcn_exp2f(__builtin_fmaf(acc[(2 * d) * 4 + nn][j], -LOG2E, ba)));
                const float ig = __builtin_amdgcn_rcpf(1.0f + __builtin_amdgcn_exp2f(__builtin_fmaf(acc[(2 * d + 1) * 4 + nn][j], -LOG2E, bx)));
                const float a_ = __builtin_amdgcn_exp2f(nsp8 * r);
                av[nn][d][j] = a_;
                bv[nn][d][j] = __builtin_amdgcn_sqrtf(__builtin_fmaf(-a_, a_, 1.0f)) * ig * uc[j];
            }
            float A = 1.f, Bq = 0.f;
            if (d == 0) {
#pragma unroll
                for (int j = 0; j < 4; ++j) { Bq = av[nn][d][j] * Bq + bv[nn][d][j]; A *= av[nn][d][j]; }
            } else {
#pragma unroll
                for (int j = 3; j >= 0; --j) { Bq = av[nn][d][j] * Bq + bv[nn][d][j]; A *= av[nn][d][j]; }
            }
            float Ag[4], Bg[4];
            rowgather4(A, Ag); rowgather4(Bq, Bg);
            float AW = 1.f, BW = 0.f, AP = 1.f, BP = 0.f;
            if (d == 0) {
#pragma unroll
                for (int g = 0; g < 4; ++g) {
                    if (g == fq) { AP = AW; BP = BW; }
                    BW = Ag[g] * BW + Bg[g]; AW *= Ag[g];
                }
            } else {
#pragma unroll
                for (int g = 3; g >= 0; --g) {
                    if (g == fq) { AP = AW; BP = BW; }
                    BW = Ag[g] * BW + Bg[g]; AW *= Ag[g];
                }
            }
            apre[nn][d] = AP; bpre[nn][d] = BP;
            if (fq == 0) { wagg[((w * 2 + d) * 64 + ch) * 2 + 0] = AW; wagg[((w * 2 + d) * 64 + ch) * 2 + 1] = BW; }
        }
    }
    __syncthreads();
    if (!PASS_C) {
        if (tid < 128) {
            const int d = tid >> 6, ch = tid & 63;
            float A = 1.f, Bq = 0.f;
            if (d == 0) {
#pragma unroll
                for (int ww = 0; ww < 4; ++ww) { const float a_ = wagg[((ww * 2 + d) * 64 + ch) * 2], b_ = wagg[((ww * 2 + d) * 64 + ch) * 2 + 1]; Bq = a_ * Bq + b_; A *= a_; }
            } else {
#pragma unroll
                for (int ww = 3; ww >= 0; --ww) { const float a_ = wagg[((ww * 2 + d) * 64 + ch) * 2], b_ = wagg[((ww * 2 + d) * 64 + ch) * 2 + 1]; Bq = a_ * Bq + b_; A *= a_; }
            }
            agg[(size_t)(b * NCH + c) * 2048 + d * 1024 + h * 64 + ch] = make_float2(A, Bq);
        }
    } else {
#pragma unroll
        for (int nn = 0; nn < 4; ++nn) {
            const int ch = 16 * nn + fr;
            float y[4];
            {
                float hw = carry[ch];
#pragma unroll
                for (int ww = 0; ww < 4; ++ww)
                    if (ww < w) hw = wagg[((ww * 2 + 0) * 64 + ch) * 2] * hw + wagg[((ww * 2 + 0) * 64 + ch) * 2 + 1];
                float hh = apre[nn][0] * hw + bpre[nn][0];
#pragma unroll
                for (int j = 0; j < 4; ++j) { hh = av[nn][0][j] * hh + bv[nn][0][j]; y[j] = hh; }
            }
            {
                float hw = carry[64 + ch];
#pragma unroll
                for (int ww = 3; ww >= 0; --ww)
                    if (ww > w) hw = wagg[((ww * 2 + 1) * 64 + ch) * 2] * hw + wagg[((ww * 2 + 1) * 64 + ch) * 2 + 1];
                float hh = apre[nn][1] * hw + bpre[nn][1];
#pragma unroll
                for (int j = 3; j >= 0; --j) { hh = av[nn][1][j] * hh + bv[nn][1][j]; y[j] += hh; }
            }
#pragma unroll
            for (int j = 0; j < 4; ++j) ytile[(16 * w + 4 * fq + j) * 66 + ch] = y[j];
        }
        __syncthreads();
        {
            const int tok = tid >> 2, cg0 = (tid & 3) * 16;
            bf16_t* MX = (bf16_t*)(p.ws + OFF_A) + (rbase + tb + tok) * 1024 + h * 64 + cg0;
#pragma unroll
            for (int i = 0; i < 2; ++i) {
                const uint4 s = i ? sg1 : sg0;
                const float* yy = ytile + tok * 66 + cg0 + 8 * i;
                uint4 o;
                o.x = pk2(yy[0] * bflo(s.x), yy[1] * bfhi(s.x)); o.y = pk2(yy[2] * bflo(s.y), yy[3] * bfhi(s.y));
                o.z = pk2(yy[4] * bflo(s.z), yy[5] * bfhi(s.z)); o.w = pk2(yy[6] * bflo(s.w), yy[7] * bfhi(s.w));
                *(uint4*)(MX + 8 * i) = o;
            }
        }
    }
}

DEVI void lru_carry_item(const P& p, int it) {
    const int gid = it * 256 + threadIdx.x, b = gid >> 11, d = (gid >> 10) & 1, ch = gid & 1023;
    const float2* ab = (const float2*)(p.ws + OFF_AGG) + (size_t)(b * NCH) * 2048 + d * 1024 + ch;
    float* cin = (float*)(p.ws + OFF_CIN) + (size_t)(b * NCH) * 2048 + d * 1024 + ch;
    float hh = 0.f;
    for (int s0 = 0; s0 < NCH; s0 += 17) {
        float2 v[17];
#pragma unroll
        for (int u_ = 0; u_ < 17; ++u_) { const int i = s0 + u_; const int cc = d == 0 ? i : (i < 4 ? 3 - i : 71 - i); v[u_] = ab[(size_t)cc * 2048]; }
#pragma unroll
        for (int u_ = 0; u_ < 17; ++u_) { const int i = s0 + u_; const int cc = d == 0 ? i : (i < 4 ? 3 - i : 71 - i); cin[(size_t)cc * 2048] = hh; hh = v[u_].x * hh + v[u_].y; }
    }
}

DEVI void attn_item(const P& p, int item, char* smem) {
    const int tid = threadIdx.x, lane = tid & 63, w = tid >> 6, fr = lane & 15, fq = lane >> 4;
    const int qt = item & 63, kvh = (item >> 6) & 3, b = item >> 8;
    const int head = kvh * 4 + w, q0 = qt * 64;
    const bf16_t* Q = (const bf16_t*)(p.ws + OFF_B) + ((size_t)(b * SEQ + q0)) * 1024 + head * 64;
    const bf16_t* KB = (const bf16_t*)(p.ws + OFF_D);
    const bf16_t* VT = (const bf16_t*)(p.ws + OFF_D + 17 * MiB);
    char* sK = smem;
    char* sV = smem + 8192;
    const float sinkv = p.sink[head] * LOG2E;
    const bf16_t* SGT = (const bf16_t*)(p.ws + OFF_C) + ((size_t)(b * SEQ + q0)) * 1024 + head * 64;
    bf16_t* OG = (bf16_t*)(p.ws + OFF_A) + ((size_t)(b * SEQ + q0)) * 1024 + head * 64;
#pragma unroll 1
    for (int mh = 0; mh < 2; ++mh) {
        const int mo = mh * 32;
        bf16x8 Qf[2][2];
#pragma unroll
        for (int m = 0; m < 2; ++m)
#pragma unroll
            for (int kk = 0; kk < 2; ++kk) Qf[m][kk] = *(const bf16x8*)(Q + (size_t)(mo + 16 * m + fr) * 1024 + kk * 32 + fq * 8);
        f32x4 O[4][2];
#pragma unroll
        for (int nd = 0; nd < 4; ++nd)
#pragma unroll
            for (int m = 0; m < 2; ++m) O[nd][m] = (f32x4){0.f, 0.f, 0.f, 0.f};
        float mrow[2], lrow[2];
#pragma unroll
        for (int m = 0; m < 2; ++m) { mrow[m] = sinkv; lrow[m] = (fq == 0) ? 1.0f : 0.0f; }

        for (int ti = 0; ti < 9; ++ti) {
            int tok0; bool lat;
            if (ti < 5) { const int kb = q0 - 128 + 64 * ti; if (kb < 0 || kb >= SEQ) continue; tok0 = CTX + kb; lat = true; }
            else { tok0 = (ti - 5) * 64; lat = false; }
            __syncthreads();
#pragma unroll
            for (int i = 0; i < 2; ++i) {
                const int row = (tid >> 3) + 32 * i, ch = tid & 7;
                const uint4 kv = *(const uint4*)(KB + ((size_t)(b * TPB + tok0 + row)) * 256 + kvh * 64 + ch * 8);
                *(uint4*)(sK + row * 128 + ((ch ^ (row & 7)) << 4)) = kv;
                const uint4 vv = *(const uint4*)(VT + ((size_t)(b * 256 + kvh * 64 + row)) * TPB + tok0 + ch * 8);
                *(uint4*)(sV + row * 128 + ((ch ^ ((row >> 1) & 7)) << 4)) = vv;
            }
            __syncthreads();
            bf16x8 Kf[4][2];
#pragma unroll
            for (int n = 0; n < 4; ++n)
#pragma unroll
                for (int kk = 0; kk < 2; ++kk) Kf[n][kk] = *(const bf16x8*)(sK + (16 * n + fr) * 128 + (((kk * 4 + fq) ^ (fr & 7)) << 4));
            bf16x8 Pf[2][2];
#pragma unroll
            for (int m = 0; m < 2; ++m) {
                f32x4 s[4];
#pragma unroll
                for (int n = 0; n < 4; ++n) {
                    s[n] = (f32x4){0.f, 0.f, 0.f, 0.f};
#pragma unroll
                    for (int kk = 0; kk < 2; ++kk) s[n] = __builtin_amdgcn_mfma_f32_16x16x32_bf16(Kf[n][kk], Qf[m][kk], s[n], 0, 0, 0);
                }
                if (lat) {
                    const int qpos = q0 + mo + 16 * m + fr, kb = tok0 - CTX;
#pragma unroll
                    for (int n = 0; n < 4; ++n)
#pragma unroll
                        for (int j = 0; j < 4; ++j) {
                            const int dd = qpos - (kb + 16 * n + 4 * fq + j);
                            if (dd > 128 || dd < -128) s[n][j] = -1e30f;
                        }
                }
                float mx = s[0][0];
#pragma unroll
                for (int n = 0; n < 4; ++n)
#pragma unroll
                    for (int j = 0; j < 4; ++j) mx = fmaxf(mx, s[n][j]);
                mx = rowmax4(mx);
                const float mnew = fmaxf(mrow[m], mx);
                const float alpha = __builtin_amdgcn_exp2f(mrow[m] - mnew);
                mrow[m] = mnew;
                float ls = 0.f;
#pragma unroll
                for (int n = 0; n < 4; ++n)
#pragma unroll
                    for (int j = 0; j < 4; ++j) { s[n][j] = __builtin_amdgcn_exp2f(s[n][j] - mnew); ls += s[n][j]; }
                lrow[m] = lrow[m] * alpha + ls;
#pragma unroll
                for (int nd = 0; nd < 4; ++nd) O[nd][m] *= alpha;
#pragma unroll
                for (int kk = 0; kk < 2; ++kk) {
                    union { uint4 u; bf16x8 v; } cv;
                    cv.u.x = pk2(s[2 * kk][0], s[2 * kk][1]); cv.u.y = pk2(s[2 * kk][2], s[2 * kk][3]);
                    cv.u.z = pk2(s[2 * kk + 1][0], s[2 * kk + 1][1]); cv.u.w = pk2(s[2 * kk + 1][2], s[2 * kk + 1][3]);
                    Pf[m][kk] = cv.v;
                }
            }
#pragma unroll
            for (int nd = 0; nd < 4; ++nd)
#pragma unroll
                for (int kk = 0; kk < 2; ++kk) {
                    const int row = 16 * nd + fr, x2 = 2 * ((row >> 1) & 7);
                    const uint2 lo = *(const uint2*)(sV + row * 128 + (((8 * kk + fq) ^ x2) << 3));
                    const uint2 hi = *(const uint2*)(sV + row * 128 + (((8 * kk + 4 + fq) ^ x2) << 3));
                    union { uint4 u; bf16x8 v; } cv;
                    cv.u.x = lo.x; cv.u.y = lo.y; cv.u.z = hi.x; cv.u.w = hi.y;
#pragma unroll
                    for (int m = 0; m < 2; ++m) O[nd][m] = __builtin_amdgcn_mfma_f32_16x16x32_bf16(cv.v, Pf[m][kk], O[nd][m], 0, 0, 0);
                }
        }
#pragma unroll
        for (int m = 0; m < 2; ++m) {
            float l = lrow[m];
            l = rowsum4(l);
            const float inv = __builtin_amdgcn_rcpf(l);
            uint2 og4[4];
#pragma unroll
            for (int nd = 0; nd < 4; ++nd) {
                const size_t off = (size_t)(mo + 16 * m + fr) * 1024 + 16 * nd + 4 * fq;
                const uint2 g = *(const uint2*)(SGT + off);
                const f32x4 v = O[nd][m] * inv;
                og4[nd].x = pk2(v[0] * bflo(g.x), v[1] * bfhi(g.x)); og4[nd].y = pk2(v[2] * bflo(g.y), v[3] * bfhi(g.y));
            }
#pragma unroll
            for (int nd = 0; nd < 4; nd += 2)
                *(uint4*)(OG + (size_t)(mo + 16 * m + fr) * 1024 + 16 * (nd + (fq & 1)) + 8 * (fq >> 1)) = widen16(og4[nd], og4[nd + 1]);
        }
    }
}

#define XB_TMO      128
#define XB_XCNT(j)  (256  + 64 * (j))
#define XB_XSUB(j)  (1280 + 64 * (j))
#define XB_XGEN(j)  (2304 + 64 * (j))
#define XB_TOP      3328
#define XB_TOPGEN   3392
#define XCD_BAR_WORDS 3456
#define XB_SPIN_CAP (1u << 22)
constexpr size_t OFF_BAR = OFF_ROPE + 32 * 1024;
DEVI unsigned xb_ld(unsigned* p) { return __hip_atomic_load(p, __ATOMIC_RELAXED, __HIP_MEMORY_SCOPE_AGENT); }
DEVI unsigned xb_add(unsigned* p, unsigned v) { return __hip_atomic_fetch_add(p, v, __ATOMIC_RELAXED, __HIP_MEMORY_SCOPE_AGENT); }
#define XB_SPIN(cond, bar) do { unsigned _sp = 0; while (cond) { __builtin_amdgcn_s_sleep(1); \
    if ((++_sp & 255u) == 0u) { if (xb_ld(&(bar)[XB_TMO])) break; if (_sp > XB_SPIN_CAP) { atomicAdd(&(bar)[XB_TMO], 1u); break; } } } } while (0)
struct XB { unsigned* bar; unsigned x, nloc, nx; };
DEVI void xb_post(XB& b, unsigned* bar) {
    b.bar = bar; b.nloc = 0u; b.nx = 0u;
    b.x = (unsigned)__builtin_amdgcn_s_getreg((3 << 11) | 20) & 0xFu;
    if (threadIdx.x == 0) (void)xb_add(&bar[XB_XCNT(b.x)], 1u);
}
DEVI void xb_complete(XB& b) {
    const unsigned G = gridDim.x;
    unsigned sum, cnt, mine, sp = 0u;
    for (;;) {
        sum = 0u; cnt = 0u; mine = 0u;
#pragma unroll
        for (unsigned j = 0; j < 16; ++j) { const unsigned c = xb_ld(&b.bar[XB_XCNT(j)]); sum += c; cnt += (c > 0u) ? 1u : 0u; mine = (j == b.x) ? c : mine; }
        if (sum == G) break;
        __builtin_amdgcn_s_sleep(1);
        if ((++sp & 255u) == 0u) { if (xb_ld(&b.bar[XB_TMO])) break; if (sp > XB_SPIN_CAP) { atomicAdd(&b.bar[XB_TMO], 1u); break; } }
    }
    b.nloc = mine > 0u ? mine : 1u; b.nx = cnt > 0u ? cnt : 1u;
}
DEVI void gsync(XB& b) {
    asm volatile("s_waitcnt vmcnt(0)" ::: "memory");
    __syncthreads();
    if (threadIdx.x == 0) {
        unsigned* bar = b.bar;
        __builtin_amdgcn_s_waitcnt(0);
        if (b.nloc == 0u) xb_complete(b);
        const unsigned nloc = b.nloc, nx = b.nx;
        const unsigned old = xb_add(&bar[XB_XSUB(b.x)], 1u);
        const unsigned gen = old / nloc;
        if (old + 1u == (gen + 1u) * nloc) {
            __builtin_amdgcn_fence(__ATOMIC_RELEASE, "agent");
            asm volatile("s_waitcnt vmcnt(0)" ::: "memory");
            const unsigned og = xb_add(&bar[XB_TOP], 1u);
            const unsigned tg = og / nx;
            if (og + 1u == (tg + 1u) * nx) xb_add(&bar[XB_TOPGEN], 1u);
            else XB_SPIN(xb_ld(&bar[XB_TOPGEN]) == tg, bar);
            __builtin_amdgcn_fence(__ATOMIC_ACQUIRE, "agent");
            xb_add(&bar[XB_XGEN(b.x)], 1u);
            asm volatile("s_waitcnt vmcnt(0)" ::: "memory");
        } else {
            XB_SPIN(xb_ld(&bar[XB_XGEN(b.x)]) == gen, bar);
            __builtin_amdgcn_fence(__ATOMIC_ACQUIRE, "agent");
            asm volatile("s_waitcnt vmcnt(0)" ::: "memory");
        }
    }
    __syncthreads();
}

__global__ void __launch_bounds__(256, 2) fwd_megakernel(P p) {
    cg::grid_group cgrid = cg::this_grid();
    extern __shared__ __attribute__((aligned(16))) char smem[];
    if (p.ws == nullptr) cgrid.sync();
    XB grid; xb_post(grid, (unsigned*)(p.ws + OFF_BAR));
    const int G = gridDim.x, bid = blockIdx.x;
    char* ws = p.ws;
    bf16_t* const bufA = (bf16_t*)(ws + OFF_A);
    bf16_t* const bufB = (bf16_t*)(ws + OFF_B);
    bf16_t* const bufC = (bf16_t*)(ws + OFF_C);
    bf16_t* const bufD = (bf16_t*)(ws + OFF_D);
    bf16_t* const PQT = (bf16_t*)(ws + OFF_E);
    bf16_t* const PQTC = (bf16_t*)(ws + OFF_E + 128 * MiB);
    const bf16_t* W0T = (const bf16_t*)(ws + OFF_W0T);
    const bf16_t* WO0T = (const bf16_t*)(ws + OFF_WO0T);
    const bf16_t* W1T = (const bf16_t*)(ws + OFF_W1T);
    const bf16_t* WO1T = (const bf16_t*)(ws + OFF_WO1T);
    const bf16_t* DC = (const bf16_t*)(ws + OFF_DC);

    for (int it = bid; it < 384 + 512; it += G) {
        if (it < 384) mods_item(p, it, (float*)smem);
        else wcs_item(p, it - 384);
    }
    gsync(grid);
    for (int it = bid; it < 256 + 2240 + 1280 + 1 + NR / 8; it += G) {
        if (it < 256) compose_item(p, it, (float*)smem);
        else if (it < 256 + 2240) transpose_job(p, it - 256, (float*)smem);
        else if (it < 256 + 2240 + 1280) dft_row_item(p, it - 256 - 2240);
        else if (it < 256 + 2240 + 1280 + 1) rope_item(p);
        else h0_rows(p, it - 256 - 2240 - 1280 - 1);
    }
    gsync(grid);
    for (int it = G - 1 - bid; it < 128; it += G) hfold_item(p, it, (float*)smem);
    {
        EpiG0A ea{bufB, bufC, bufD};
        EpiG0B eb{PQT, PQTC};
        constexpr int NT2 = 136 * 24 + 128;
        auto desc = [&](int L, G2Tile& t) {
            int pm, pn;
            if (L < 136 * 24) { tile_map(L, 136, 24, pm, pn); t.Bt = W0T + (size_t)pn * 128 * 1024; t.aux = 1; }
            else { const int j = L - 136 * 24; pm = (j >> 4) * 17; pn = j & 15; t.Bt = W0T + (size_t)(3072 + pn * 128) * 1024; t.aux = 0; }
            t.A = bufA + (size_t)pm * 256 * 1024; t.lda = 1024; t.ldb = 1024; t.nk = 32; t.row0 = pm * 256; t.col0 = pn * 128;
        };
        int st = 0;
        G2Tile t, nx;
        if (bid < NT2) { desc(bid, t); __syncthreads(); g2_prologue(t, 0, smem); }
        for (int L = bid; L < NT2; L += G) {
            const bool hn = L + G < NT2;
            if (hn) desc(L + G, nx);
            if (t.aux) st = g2_body<true>(t, st, smem, hn, nx, ea); else st = g2_body<false>(t, st, smem, hn, nx, eb);
            t = nx;
        }
    }
    gsync(grid);
    if (bid < (G >> 1)) {
    {
        __builtin_amdgcn_s_setprio(2);
        int cur_h = -1; uint4 u0, u1, u2; float cpre = 0.f;
        if (bid < NB * NCH * 16) lru_load_us(p, bid, threadIdx.x, u0, u1, u2);
        for (int it = bid; it < NB * NCH * 16; it += G) {
            if ((it & 15) != cur_h) { cur_h = it & 15; lru_preload(p, cur_h, smem); }
            lru_item<false>(p, it, it + G < NB * NCH * 16 ? it + G : -1, u0, u1, u2, cpre, smem);
        }
        __builtin_amdgcn_s_setprio(0);
    }
    for (int it = bid; it < 512; it += G) fspecial_item(p, it, (float*)smem);
    {
        int st = 0; G2Tile t, nx;
        auto desc = [&](int L, G2Tile& q) { const int b = L >> 7, fam = (L >> 5) & 3; int pm, pn; tile_map(L & 31, 4, 8, pm, pn);
            q.A = (const bf16_t*)(ws + OFF_HF) + ((size_t)(b * 4 + fam) * 1024 + pm * 256) * 1024;
            q.Bt = W0T + (size_t)(3072 + (fam >> 1) * 1024 + pn * 128) * 1024;
            q.lda = 1024; q.ldb = 1024; q.nk = 32; q.row0 = pm * 256; q.col0 = pn * 128; q.aux = b * 4 + fam; };
        if (bid < 1024) { desc(bid, t); __syncthreads(); g2_prologue(t, 0, smem); }
        for (int L = bid; L < 1024; L += G) {
            const bool hn = L + G < 1024;
            if (hn) desc(L + G, nx);
            const int b = t.aux >> 2, fam = t.aux & 3;
            EpiFoldT ef{(bf16_t*)(ws + ((fam & 2) ? OFF_QF : OFF_PE) + (size_t)(fam & 1) * 16 * MiB) + (size_t)b * 1048576};
            st = g2_body<false>(t, st, smem, hn, nx, ef);
            t = nx;
        }
        EpiDFT edc{bufD, p.b_f, 0.005524271728019903f  };
        for (int L = G - 1 - bid; L < 128; L += G) {
            const int b = L >> 4, pm = (L >> 3) & 1, pn = L & 7;
            gemm_tile<true>(DC + (size_t)pm * 128 * 512, DC, 1 << 30, 512, PQTC + (size_t)(b * 1024 + pn * 128) * 512, 512, 8, smem, edc, b * TPB + pm * 128, pn * 128);
        }
    }
    } else {
    for (int it = bid; it < 512; it += G) fspecial_item(p, it, (float*)smem);
    {
        int st = 0; G2Tile t, nx;
        auto desc = [&](int L, G2Tile& q) { const int b = L >> 7, fam = (L >> 5) & 3; int pm, pn; tile_map(L & 31, 4, 8, pm, pn);
            q.A = (const bf16_t*)(ws + OFF_HF) + ((size_t)(b * 4 + fam) * 1024 + pm * 256) * 1024;
            q.Bt = W0T + (size_t)(3072 + (fam >> 1) * 1024 + pn * 128) * 1024;
            q.lda = 1024; q.ldb = 1024; q.nk = 32; q.row0 = pm * 256; q.col0 = pn * 128; q.aux = b * 4 + fam; };
        if (bid < 1024) { desc(bid, t); __syncthreads(); g2_prologue(t, 0, smem); }
        for (int L = bid; L < 1024; L += G) {
            const bool hn = L + G < 1024;
            if (hn) desc(L + G, nx);
            const int b = t.aux >> 2, fam = t.aux & 3;
            EpiFoldT ef{(bf16_t*)(ws + ((fam & 2) ? OFF_QF : OFF_PE) + (size_t)(fam & 1) * 16 * MiB) + (size_t)b * 1048576};
            st = g2_body<false>(t, st, smem, hn, nx, ef);
            t = nx;
        }
        EpiDFT edc{bufD, p.b_f, 0.005524271728019903f  };
        for (int L = G - 1 - bid; L < 128; L += G) {
            const int b = L >> 4, pm = (L >> 3) & 1, pn = L & 7;
            gemm_tile<true>(DC + (size_t)pm * 128 * 512, DC, 1 << 30, 512, PQTC + (size_t)(b * 1024 + pn * 128) * 512, 512, 8, smem, edc, b * TPB + pm * 128, pn * 128);
        }
    }
    {
        __builtin_amdgcn_s_setprio(2);
        int cur_h = -1; uint4 u0, u1, u2; float cpre = 0.f;
        if (bid < NB * NCH * 16) lru_load_us(p, bid, threadIdx.x, u0, u1, u2);
        for (int it = bid; it < NB * NCH * 16; it += G) {
            if ((it & 15) != cur_h) { cur_h = it & 15; lru_preload(p, cur_h, smem); }
            lru_item<false>(p, it, it + G < NB * NCH * 16 ? it + G : -1, u0, u1, u2, cpre, smem);
        }
        __builtin_amdgcn_s_setprio(0);
    }
    }
    gsync(grid);
    for (int it = bid; it < 64; it += G) lru_carry_item(p, it);
    gsync(grid);
    if (bid < (G >> 1)) {
    {
        int st = 0; G2Tile tc, ts, nx;
        auto desc = [&](int L, int sn, G2Tile& q) { const int b = L >> 6, par = (L >> 5) & 1; int pm, pn; tile_map(L & 31, 4, 8, pm, pn);
            q.A = (const bf16_t*)(ws + OFF_DL + (size_t)(2 * sn + par) * 2 * MiB) + (size_t)pm * 256 * 1024;
            q.Bt = (const bf16_t*)(ws + (sn ? OFF_QF : OFF_PE) + (size_t)par * 16 * MiB) + (size_t)(b * 1024 + pn * 128) * 1024;
            q.lda = 1024; q.ldb = 1024; q.nk = 32; q.row0 = pm * 256; q.col0 = pn * 128; q.aux = b * 2 + par; };
        if (bid < 512) { desc(bid, 0, tc); __syncthreads(); g2_prologue(tc, 0, smem); }
        for (int L = bid; L < 512; L += G) {
            desc(L, 1, ts);
            const bool hn = L + G < 512;
            if (hn) desc(L + G, 0, nx);
            EpiYc eyc{(float*)(ws + OFF_T), (const float*)(ws + OFF_PS1024), tc.aux >> 1, tc.aux & 1};
            st = g2_body<true>(tc, st, smem, true, ts, eyc);
            EpiYs eys{(const float*)(ws + OFF_T), bufD, p.b_f, 0.0013810679320049757f  , (const float*)(ws + OFF_QS1024), ts.aux >> 1, ts.aux & 1};
            st = g2_body<true>(ts, st, smem, hn, nx, eys);
            tc = nx;
        }
    }
    {
        __builtin_amdgcn_s_setprio(2);
        int cur_h = -1; uint4 u0, u1, u2; float cpre = 0.f;
        if (bid < NB * NCH * 16) {
            lru_load_us(p, bid, threadIdx.x, u0, u1, u2);
            if (threadIdx.x < 128) { const int nh = bid & 15, nc = (bid >> 4) % NCH, nb = bid / (16 * NCH);
                cpre = ((const float*)(ws + OFF_CIN))[(size_t)(nb * NCH + nc) * 2048 + (threadIdx.x >> 6) * 1024 + nh * 64 + (threadIdx.x & 63)]; }
        }
        for (int it = bid; it < NB * NCH * 16; it += G) {
            if ((it & 15) != cur_h) { cur_h = it & 15; lru_preload(p, cur_h, smem); }
            lru_item<true>(p, it, it + G < NB * NCH * 16 ? it + G : -1, u0, u1, u2, cpre, smem);
        }
        __builtin_amdgcn_s_setprio(0);
    }
    } else {
    {
        __builtin_amdgcn_s_setprio(2);
        int cur_h = -1; uint4 u0, u1, u2; float cpre = 0.f;
        if (bid < NB * NCH * 16) {
            lru_load_us(p, bid, threadIdx.x, u0, u1, u2);
            if (threadIdx.x < 128) { const int nh = bid & 15, nc = (bid >> 4) % NCH, nb = bid / (16 * NCH);
                cpre = ((const float*)(ws + OFF_CIN))[(size_t)(nb * NCH + nc) * 2048 + (threadIdx.x >> 6) * 1024 + nh * 64 + (threadIdx.x & 63)]; }
        }
        for (int it = bid; it < NB * NCH * 16; it += G) {
            if ((it & 15) != cur_h) { cur_h = it & 15; lru_preload(p, cur_h, smem); }
            lru_item<true>(p, it, it + G < NB * NCH * 16 ? it + G : -1, u0, u1, u2, cpre, smem);
        }
        __builtin_amdgcn_s_setprio(0);
    }
    {
        int st = 0; G2Tile tc, ts, nx;
        auto desc = [&](int L, int sn, G2Tile& q) { const int b = L >> 6, par = (L >> 5) & 1; int pm, pn; tile_map(L & 31, 4, 8, pm, pn);
            q.A = (const bf16_t*)(ws + OFF_DL + (size_t)(2 * sn + par) * 2 * MiB) + (size_t)pm * 256 * 1024;
            q.Bt = (const bf16_t*)(ws + (sn ? OFF_QF : OFF_PE) + (size_t)par * 16 * MiB) + (size_t)(b * 1024 + pn * 128) * 1024;
            q.lda = 1024; q.ldb = 1024; q.nk = 32; q.row0 = pm * 256; q.col0 = pn * 128; q.aux = b * 2 + par; };
        if (bid < 512) { desc(bid, 0, tc); __syncthreads(); g2_prologue(tc, 0, smem); }
        for (int L = bid; L < 512; L += G) {
            desc(L, 1, ts);
            const bool hn = L + G < 512;
            if (hn) desc(L + G, 0, nx);
            EpiYc eyc{(float*)(ws + OFF_T), (const float*)(ws + OFF_PS1024), tc.aux >> 1, tc.aux & 1};
            st = g2_body<true>(tc, st, smem, true, ts, eyc);
            EpiYs eys{(const float*)(ws + OFF_T), bufD, p.b_f, 0.0013810679320049757f  , (const float*)(ws + OFF_QS1024), ts.aux >> 1, ts.aux & 1};
            st = g2_body<true>(ts, st, smem, hn, nx, eys);
            tc = nx;
        }
    }
    }
    gsync(grid);
    {
        EpiBf16 ef{(bf16_t*)(ws + OFF_E)};
        for (int L = bid; L < 272 * 8; L += G) {
            int pm, pn; tile_map(L, 272, 8, pm, pn);
            gemm_tile<true>(bufA + (size_t)pm * 128 * 1024, bufD + (size_t)pm * 128 * 1024, 16, 1024, WO0T + (size_t)pn * 128 * 2048, 2048, 32, smem, ef, pm * 128, pn * 128);
        }
    }
    gsync(grid);
    for (int it = bid; it < NR / 8; it += G) norm1_rows(p, it);
    gsync(grid);
    {
        EpiG2A ea{bufB, bufD, bufC, (const float*)(ws + OFF_ROPE), (const float*)(ws + OFF_ROPE) + 1024};
        for (int L = bid; L < 272 * 18; L += G) {
            int pm, pn; tile_map(L, 272, 18, pm, pn);
            const bool isctx = (pm % 34) < 2;
            if (isctx && (pn < 8 || pn > 9)) continue;
            gemm_tile<true>(bufA + (size_t)pm * 128 * 1024, bufA, 1 << 30, 1024, W1T + (size_t)pn * 128 * 1024, 1024, 16, smem, ea, pm * 128, pn * 128);
        }
        EpiG2B eb{(bf16_t*)(ws + OFF_D + 17 * MiB)};
        for (int L = bid; L < 272 * 2; L += G) {
            int pm, pn; tile_map(L, 272, 2, pm, pn);
            gemm_tile<false>(bufA + (size_t)pm * 128 * 1024, bufA, 1 << 30, 1024, W1T + (size_t)(2304 + pn * 128) * 1024, 1024, 16, smem, eb, pm * 128, pn * 128);
        }
    }
    gsync(grid);
    for (int it = bid; it < NB * 4 * 64; it += G) attn_item(p, it, smem);
    gsync(grid);
    {
        EpiBf16 ef{(bf16_t*)(ws + OFF_E)};
        {
            int st = 0; G2Tile t, nx;
            auto desc = [&](int L, G2Tile& q) { int pm, pn; tile_map(L, 128, 8, pm, pn);
                q.A = bufA + (size_t)pm * 256 * 1024; q.Bt = WO1T + (size_t)pn * 128 * 1024; q.lda = 1024; q.ldb = 1024; q.nk = 32; q.row0 = pm * 256; q.col0 = pn * 128; q.aux = 0; };
            if (bid < 1024) { desc(bid, t); __syncthreads(); g2_prologue(t, 0, smem); }
            for (int L = bid; L < 1024; L += G) {
                const bool hn = L + G < 1024;
                if (hn) desc(L + G, nx);
                st = g2_body<true>(t, st, smem, hn, nx, ef);
                t = nx;
            }
        }
    }
    gsync(grid);
    for (int it = bid; it < NB * SEQ / 8; it += G) final_rows(p, it);
}

extern "C" void kernel_launch(void* const* d_in, const int* in_sizes, int n_in, void* d_out, int out_size, void* d_ws, size_t ws_size,
                              hipStream_t stream) {
    static int grid_blocks = 0;
    if (!grid_blocks) {
        int dev = 0, cus = 0, per_cu = 0;
        (void)hipGetDevice(&dev);
        (void)hipDeviceGetAttribute(&cus, hipDeviceAttributeMultiprocessorCount, dev);
        (void)hipFuncSetAttribute((const void*)fwd_megakernel, hipFuncAttributeMaxDynamicSharedMemorySize, 73728);
        (void)hipOccupancyMaxActiveBlocksPerMultiprocessor(&per_cu, fwd_megakernel, 256, 73728);
        if (per_cu > 2) per_cu = 2;
        if (per_cu < 1) per_cu = 1;
        grid_blocks = cus * per_cu;
    }
    P p{};
    const float* const* in = (const float* const*)d_in;
    p.x = in[0]; p.c = in[1]; p.ctx = in[2]; p.c_ctx = in[3];
    p.w_mod0 = in[4]; p.b_mod0 = in[5]; p.g_pre0 = in[6]; p.g_post0 = in[7]; p.w_in0 = in[8]; p.w_conv = in[9]; p.b_conv = in[10];
    p.w_a = in[11]; p.b_a = in[12]; p.w_x = in[13]; p.b_x = in[14]; p.lam = in[15]; p.w_f = in[16]; p.b_f = in[17]; p.w_out0 = in[18];
    p.w_mod1 = in[19]; p.b_mod1 = in[20]; p.g_pre1 = in[21]; p.g_post1 = in[22]; p.w_in1 = in[23]; p.sink = in[24]; p.w_out1 = in[25];
    p.out = (float*)d_out;
    p.ws = (char*)d_ws;
    void* args[] = {&p};
    (void)hipMemsetAsync((char*)d_ws + OFF_BAR, 0, XCD_BAR_WORDS * 4, stream);
    hipError_t e = hipLaunchCooperativeKernel((void*)fwd_megakernel, dim3(grid_blocks), dim3(256), args, 73728, stream);
    if (e != hipSuccess) fprintf(stderr, "cooperative launch failed: %s (grid %d)\n", hipGetErrorString(e), grid_blocks);
}
```

```cpp
#include <hip/hip_runtime.h>
#include <hip/hip_cooperative_groups.h>
#include <cstdio>
namespace cg = cooperative_groups;

typedef unsigned short bf16_t;
typedef short bf16x8 __attribute__((ext_vector_type(8)));
typedef float f32x4 __attribute__((ext_vector_type(4)));
#define DEVI __device__ __forceinline__

constexpr int NB = 8, SEQ = 4096, CTX = 256, DM = 1024, TPB = SEQ + CTX  , NR = NB * TPB  ;
constexpr int NCH = TPB / 64;
constexpr float LOG2E = 1.4426950408889634f;

constexpr size_t MiB = 1ull << 20;
constexpr size_t OFF_A = 0;
constexpr size_t OFF_B = 68 * MiB;
constexpr size_t OFF_C = 136 * MiB;
constexpr size_t OFF_D = 204 * MiB;
constexpr size_t OFF_E = 272 * MiB;
constexpr size_t OFF_W0T = 408 * MiB;
constexpr size_t OFF_WO0T = 418 * MiB;
constexpr size_t OFF_W1T = 422 * MiB;
constexpr size_t OFF_WO1T = 427 * MiB;
constexpr size_t OFF_DL = 429 * MiB;
constexpr size_t OFF_QF = OFF_DL + 16 * MiB;
constexpr size_t OFF_DC = 493 * MiB;
constexpr size_t OFF_WG = OFF_DC + 256 * 1024;
constexpr size_t OFF_WCS = 494 * MiB;
constexpr size_t OFF_MODS = 495 * MiB;
constexpr size_t OFF_ROPE = OFF_MODS + 256 * 1024;
constexpr size_t OFF_AGG = 496 * MiB;

struct P {
    const float *x, *c, *ctx, *c_ctx;
    const float *w_mod0, *b_mod0, *g_pre0, *g_post0, *w_in0, *w_conv, *b_conv, *w_a, *b_a, *w_x, *b_x, *lam, *w_f, *b_f, *w_out0;
    const float *w_mod1, *b_mod1, *g_pre1, *g_post1, *w_in1, *sink, *w_out1;
    float* out;
    char* ws;
};

DEVI int opaque_tid() { int t = (int)threadIdx.x; asm volatile("" : "+v"(t)); return t; }
DEVI float bf2f(bf16_t h) { return __uint_as_float(((unsigned)h) << 16); }
typedef float f32x2 __attribute__((ext_vector_type(2)));
typedef __bf16 bf16x2_t __attribute__((ext_vector_type(2)));
DEVI unsigned pk2(float lo, float hi) { f32x2 v = {lo, hi}; bf16x2_t b = __builtin_convertvector(v, bf16x2_t); return __builtin_bit_cast(unsigned, b); }
DEVI float bflo(unsigned u) { return __uint_as_float(u << 16); }
DEVI float bfhi(unsigned u) { return __uint_as_float(u & 0xffff0000u); }
DEVI float sigmoidf_(float x) { return __builtin_amdgcn_rcpf(1.0f + __expf(-x)); }
DEVI float siluf_(float x) { return x * sigmoidf_(x); }
DEVI float rowmax4(float v) {
    const auto a = __builtin_amdgcn_permlane32_swap(__float_as_uint(v), __float_as_uint(v), false, false);
    const float m = fmaxf(__uint_as_float(a[0]), __uint_as_float(a[1]));
    const auto b = __builtin_amdgcn_permlane16_swap(__float_as_uint(m), __float_as_uint(m), false, false);
    return fmaxf(__uint_as_float(b[0]), __uint_as_float(b[1]));
}
DEVI float rowsum4(float v) {
    const auto a = __builtin_amdgcn_permlane32_swap(__float_as_uint(v), __float_as_uint(v), false, false);
    const float m = __uint_as_float(a[0]) + __uint_as_float(a[1]);
    const auto b = __builtin_amdgcn_permlane16_swap(__float_as_uint(m), __float_as_uint(m), false, false);
    return __uint_as_float(b[0]) + __uint_as_float(b[1]);
}
DEVI void rowgather4(float v, float (&g)[4]) {
    const auto s16 = __builtin_amdgcn_permlane16_swap(__float_as_uint(v), __float_as_uint(v), false, false);
    const auto se = __builtin_amdgcn_permlane32_swap(s16[0], s16[0], false, false);
    const auto so = __builtin_amdgcn_permlane32_swap(s16[1], s16[1], false, false);
    g[0] = __uint_as_float(se[0]); g[1] = __uint_as_float(so[0]); g[2] = __uint_as_float(se[1]); g[3] = __uint_as_float(so[1]);
}
DEVI float wave_sum(float v) {
#pragma unroll
    for (int o = 32; o > 0; o >>= 1) v += __shfl_xor(v, o);
    return v;
}

template <bool TRANS, class Epi>
DEVI void gemm_tile(const bf16_t* __restrict__ A0, const bf16_t* __restrict__ A1, int ksplit, int lda,
                    const bf16_t* __restrict__ Bt, int ldb, int nk, char* smem, const Epi& epi, int row0, int col0) {
    const int tid = opaque_tid(), lane = tid & 63, w = tid >> 6, wr = w >> 1, wc = w & 1, fr = lane & 15, fq = lane >> 4;
    f32x4 acc[4][4];
#pragma unroll
    for (int m = 0; m < 4; ++m)
#pragma unroll
        for (int n = 0; n < 4; ++n) acc[m][n] = (f32x4){0.f, 0.f, 0.f, 0.f};
    const int srow = w * 8 + (lane >> 3), sch = (lane & 7) ^ ((lane >> 3) & 7);
    const size_t aoff = (size_t)srow * lda + sch * 8, boff = (size_t)srow * ldb + sch * 8;
    const int ldsoff = w * 1024 + lane * 16;
    auto issue = [&](int kt, int buf) {
        const bf16_t* ap = (kt < ksplit ? A0 + (size_t)kt * 64 : A1 + (size_t)(kt - ksplit) * 64) + aoff;
        const bf16_t* bp = Bt + (size_t)kt * 64 + boff;
        char* sa = smem + buf * 32768 + ldsoff;
        char* sb = sa + 16384;
#pragma unroll
        for (int i = 0; i < 4; ++i) __builtin_amdgcn_global_load_lds((const unsigned*)(ap + (size_t)(32 * i) * lda), (unsigned*)(sa + i * 4096), 16, 0, 0);
#pragma unroll
        for (int i = 0; i < 4; ++i) __builtin_amdgcn_global_load_lds((const unsigned*)(bp + (size_t)(32 * i) * ldb), (unsigned*)(sb + i * 4096), 16, 0, 0);
    };
    __syncthreads();
    issue(0, 0);
    asm volatile("s_waitcnt vmcnt(0)" ::: "memory");
    __syncthreads();
    for (int kt = 0; kt < nk; ++kt) {
        const int buf = kt & 1;
        if (kt + 1 < nk) issue(kt + 1, buf ^ 1);
        const char* sa = smem + buf * 32768;
        const char* sb = sa + 16384;
#pragma unroll
        for (int kk = 0; kk < 2; ++kk) {
            bf16x8 af[4], bfr[4];
            const int cho = (((kk * 4 + fq) ^ (fr & 7)) << 4);
#pragma unroll
            for (int m = 0; m < 4; ++m) af[m] = *(const bf16x8*)(sa + (wr * 64 + 16 * m + fr) * 128 + cho);
#pragma unroll
            for (int n = 0; n < 4; ++n) bfr[n] = *(const bf16x8*)(sb + (wc * 64 + 16 * n + fr) * 128 + cho);
            __builtin_amdgcn_s_setprio(1);
#pragma unroll
            for (int m = 0; m < 4; ++m)
#pragma unroll
                for (int n = 0; n < 4; ++n)
                    acc[m][n] = TRANS ? __builtin_amdgcn_mfma_f32_16x16x32_bf16(bfr[n], af[m], acc[m][n], 0, 0, 0)
                                      : __builtin_amdgcn_mfma_f32_16x16x32_bf16(af[m], bfr[n], acc[m][n], 0, 0, 0);
            __builtin_amdgcn_s_setprio(0);
        }
        asm volatile("s_waitcnt vmcnt(0)" ::: "memory");
        __syncthreads();
    }
    epi.template operator()<4>(acc, row0 + wr * 64, col0 + wc * 64, fr, fq);
}

DEVI void tile_map(int L, int nM, int nN, int& pm, int& pn) {
    const int nwg = nM * nN, q = nwg >> 3, r = nwg & 7, xcd = L & 7, off = L >> 3;
    const int wgid = (xcd < r ? xcd * (q + 1) : r * (q + 1) + (xcd - r) * q) + off;
    const int WGM = 8, nig = WGM * nN, gid = wgid / nig, fm = gid * WGM, gsz = (nM - fm) < WGM ? (nM - fm) : WGM;
    pm = fm + ((wgid % nig) % gsz);
    pn = (wgid % nig) / gsz;
}

struct G2Tile { const bf16_t* A; const bf16_t* Bt; int lda, ldb, nk, row0, col0, aux; };
DEVI void g2_issue(const G2Tile& t, int kt, int st, char* smem) {
    const int tid = opaque_tid(), lane = tid & 63, w = tid >> 6;
    const int rr = lane >> 2, sch = (lane & 3) ^ ((lane >> 5) << 1);
    const bf16_t* ap = t.A + (size_t)kt * 32 + (size_t)(w * 16 + rr) * t.lda + sch * 8;
    const bf16_t* bp = t.Bt + (size_t)kt * 32 + (size_t)(w * 16 + rr) * t.ldb + sch * 8;
    char* sa = smem + st * 24576 + w * 1024 + lane * 16;
#pragma unroll
    for (int i = 0; i < 4; ++i) __builtin_amdgcn_global_load_lds((const unsigned*)(ap + (size_t)(64 * i) * t.lda), (unsigned*)(sa + i * 4096), 16, 0, 0);
#pragma unroll
    for (int i = 0; i < 2; ++i) __builtin_amdgcn_global_load_lds((const unsigned*)(bp + (size_t)(64 * i) * t.ldb), (unsigned*)(sa + 16384 + i * 4096), 16, 0, 0);
}
DEVI void g2_prologue(const G2Tile& t, int st, char* smem) {
    g2_issue(t, 0, st, smem);
    g2_issue(t, 1, st == 2 ? 0 : st + 1, smem);
}
template <bool TRANS, class Epi>
DEVI int g2_body(const G2Tile& t, int st, char* smem, bool has_next, const G2Tile& nxt, const Epi& epi) {
    const int tid = opaque_tid(), lane = tid & 63, w = tid >> 6, wr = w >> 1, wc = w & 1, fr = lane & 15, fq = lane >> 4;
    f32x4 acc[8][4];
#pragma unroll
    for (int m = 0; m < 8; ++m)
#pragma unroll
        for (int n = 0; n < 4; ++n) acc[m][n] = (f32x4){0.f, 0.f, 0.f, 0.f};
    const int frag = fr * 64 + ((fq ^ ((fr >> 3) << 1)) << 4);
    const int nk = t.nk;
    for (int kt = 0; kt < nk; ++kt) {
        if (kt + 1 < nk) asm volatile("s_waitcnt vmcnt(6)" ::: "memory");
        else asm volatile("s_waitcnt vmcnt(0)" ::: "memory");
        __syncthreads();
        if (kt + 2 < nk) g2_issue(t, kt + 2, st >= 1 ? st - 1 : 2, smem);
        const char* sa = smem + st * 24576 + frag;
        bf16x8 bfr[4];
#pragma unroll
        for (int n = 0; n < 4; ++n) bfr[n] = *(const bf16x8*)(sa + (16 + wc * 4 + n) * 1024);
#pragma unroll
        for (int mh = 0; mh < 2; ++mh) {
            bf16x8 af[4];
#pragma unroll
            for (int m = 0; m < 4; ++m) af[m] = *(const bf16x8*)(sa + (wr * 8 + mh * 4 + m) * 1024);
            __builtin_amdgcn_s_setprio(1);
#pragma unroll
            for (int m = 0; m < 4; ++m)
#pragma unroll
                for (int n = 0; n < 4; ++n)
                    acc[mh * 4 + m][n] = TRANS ? __builtin_amdgcn_mfma_f32_16x16x32_bf16(bfr[n], af[m], acc[mh * 4 + m][n], 0, 0, 0)
                                               : __builtin_amdgcn_mfma_f32_16x16x32_bf16(af[m], bfr[n], acc[mh * 4 + m][n], 0, 0, 0);
            __builtin_amdgcn_s_setprio(0);
        }
        st = st == 2 ? 0 : st + 1;
    }
    if (has_next) g2_prologue(nxt, st, smem);
    epi.template operator()<8>(acc, t.row0 + wr * 128, t.col0 + wc * 64, fr, fq);
    return st;
}

DEVI uint4 widen16(uint2 x, uint2 y) {
    const auto r0 = __builtin_amdgcn_permlane16_swap(x.x, y.x, false, false);
    const auto r1 = __builtin_amdgcn_permlane16_swap(x.y, y.y, false, false);
    uint4 o; o.x = r0[0]; o.y = r1[0]; o.z = r0[1]; o.w = r1[1];
    return o;
}

struct EpiG0A {
    bf16_t *u, *sg, *sgf;
    template <int MT> DEVI void operator()(f32x4 (&acc)[MT][4], int row0, int col0, int fr, int fq) const {
        const int type = col0 >> 10;
        bf16_t* dst = type == 0 ? u : (type == 1 ? sg : sgf);
        const int cb = (col0 & 1023) + 16 * (fq & 1) + 8 * (fq >> 1);
#pragma unroll
        for (int m = 0; m < MT; ++m) {
            __builtin_amdgcn_sched_barrier(0);
            bf16_t* rp = dst + (size_t)(row0 + 16 * m + fr) * 1024 + cb;
#pragma unroll
            for (int n = 0; n < 4; n += 2) {
                f32x4 v = acc[m][n], w_ = acc[m][n + 1];
                if (type) { v[0] = siluf_(v[0]); v[1] = siluf_(v[1]); v[2] = siluf_(v[2]); v[3] = siluf_(v[3]);
                            w_[0] = siluf_(w_[0]); w_[1] = siluf_(w_[1]); w_[2] = siluf_(w_[2]); w_[3] = siluf_(w_[3]); }
                uint2 x, y; x.x = pk2(v[0], v[1]); x.y = pk2(v[2], v[3]); y.x = pk2(w_[0], w_[1]); y.y = pk2(w_[2], w_[3]);
                *(uint4*)(rp + 16 * n) = widen16(x, y);
            }
        }
    }
};
struct EpiG0B {
    bf16_t *pqt, *pqtc;
    template <int MT> DEVI void operator()(f32x4 (&acc)[MT][4], int row0, int col0, int fr, int fq) const {
        const int isq = col0 >> 10;
        const int b = row0 / TPB, t0 = row0 - b * TPB;
#pragma unroll
        for (int m = 0; m < MT; ++m)
#pragma unroll
            for (int n = 0; n < 4; ++n) {
                const int e = (col0 & 1023) + 16 * n + fr;
                const int t = t0 + 16 * m + 4 * fq;
                f32x4 v = acc[m][n];
                uint2 o; o.x = pk2(v[0], v[1]); o.y = pk2(v[2], v[3]);
                bf16_t* dst = (t < CTX) ? pqtc + ((size_t)(b * 1024 + e)) * 512 + isq * 256 + t
                                        : pqt + ((size_t)(b * 1024 + e)) * 8192 + isq * 4096 + (t - CTX);
                *(uint2*)dst = o;
            }
    }
};
struct EpiDFT {
    bf16_t* sgf; const float* bfv; float scale;
    template <int MT> DEVI void operator()(f32x4 (&acc)[MT][4], int row0, int col0, int fr, int fq) const {
#pragma unroll
        for (int n = 0; n < 4; ++n) {
            const int col = col0 + 16 * n + 4 * fq;
            const f32x4 bb = *(const f32x4*)(bfv + col);
#pragma unroll
            for (int m = 0; m < MT; ++m) {
                bf16_t* ptr = sgf + (size_t)(row0 + 16 * m + fr) * 1024 + col;
                const uint2 s = *(const uint2*)ptr;
                f32x4 v = acc[m][n] * scale + bb;
                uint2 o; o.x = pk2(v[0] * bflo(s.x), v[1] * bfhi(s.x)); o.y = pk2(v[2] * bflo(s.y), v[3] * bfhi(s.y));
                *(uint2*)ptr = o;
            }
        }
    }
};
struct EpiYc {
    float* T; const float* ps1024; int b, par;
    template <int MT> DEVI void operator()(f32x4 (&acc)[MT][4], int row0, int col0, int fr, int fq) const {
#pragma unroll
        for (int n = 0; n < 4; ++n) {
            const int e = col0 + 16 * n + 4 * fq;
            f32x4 pv = *(const f32x4*)(ps1024 + b * 1024 + e);
            if (par) pv = (f32x4){0.f, 0.f, 0.f, 0.f};
#pragma unroll
            for (int m = 0; m < MT; ++m) {
                const int k = row0 + 16 * m + fr;
                const float sg = (k & 1) ? -1.0f : 1.0f;
                *(f32x4*)(T + ((size_t)((b * 2 + par) * 1024 + k)) * 1024 + e) = acc[m][n] + pv * sg;
            }
        }
    }
};
struct EpiYs {
    const float* T; bf16_t* sgf; const float* bfv; float scale; const float* qs1024; int b, par;
    template <int MT> DEVI void operator()(f32x4 (&acc)[MT][4], int row0, int col0, int fr, int fq) const {
        const float sg = (float)(par * (1 - 2 * (fr & 1)));
        f32x4 qt[4];
#pragma unroll
        for (int n = 0; n < 4; ++n) qt[n] = *(const f32x4*)(qs1024 + b * 1024 + col0 + 16 * n + 4 * fq) * sg;
#pragma unroll
        for (int m = 0; m < MT; ++m) {
            __builtin_amdgcn_sched_barrier(0);
            const int kp = row0 + 16 * m + fr, k = 2 * kp + par;
            const float* trow = T + ((size_t)((b * 2 + par) * 1024 + kp)) * 1024 + col0 + 4 * fq;
            bf16_t* p1 = sgf + (size_t)(b * TPB + CTX + k) * 1024 + col0 + 4 * fq;
            bf16_t* p2 = sgf + (size_t)(b * TPB + CTX + 4096 - k) * 1024 + col0 + 4 * fq;
            uint2 o1[4], o2[4];
#pragma unroll
            for (int n = 0; n < 4; ++n) {
                const f32x4 bb = *(const f32x4*)(bfv + col0 + 16 * n + 4 * fq);
                const f32x4 yc = *(const f32x4*)(trow + 16 * n);
                const f32x4 ys = acc[m][n] + qt[n];
                {
                    const uint2 s = *(const uint2*)(p1 + 16 * n);
                    const f32x4 v = (yc - ys) * scale + bb;
                    o1[n].x = pk2(v[0] * bflo(s.x), v[1] * bfhi(s.x)); o1[n].y = pk2(v[2] * bflo(s.y), v[3] * bfhi(s.y));
                }
                o2[n].x = 0u; o2[n].y = 0u;
                if (k >= 1) {
                    const uint2 s = *(const uint2*)(p2 + 16 * n);
                    const f32x4 v = (yc + ys) * scale + bb;
                    o2[n].x = pk2(v[0] * bflo(s.x), v[1] * bfhi(s.x)); o2[n].y = pk2(v[2] * bflo(s.y), v[3] * bfhi(s.y));
                }
            }
            const int wo = 16 * (fq & 1) + 8 * (fq >> 1) - 4 * fq;
#pragma unroll
            for (int n = 0; n < 4; n += 2) {
                const uint4 a1 = widen16(o1[n], o1[n + 1]), a2 = widen16(o2[n], o2[n + 1]);
                *(uint4*)(p1 + wo + 16 * n) = a1;
                if (k >= 1) *(uint4*)(p2 + wo + 16 * n) = a2;
            }
        }
    }
};
struct EpiFoldT {
    bf16_t* dst;
    template <int MT> DEVI void operator()(f32x4 (&acc)[MT][4], int row0, int col0, int fr, int fq) const {
#pragma unroll
        for (int m = 0; m < MT; ++m)
#pragma unroll
            for (int n = 0; n < 4; n += 2) {
                const f32x4 v = acc[m][n], w_ = acc[m][n + 1];
                uint2 x, y; x.x = pk2(v[0], v[1]); x.y = pk2(v[2], v[3]); y.x = pk2(w_[0], w_[1]); y.y = pk2(w_[2], w_[3]);
                *(uint4*)(dst + (size_t)(col0 + 16 * (n + (fq & 1)) + fr) * 1024 + row0 + 16 * m + 8 * (fq >> 1)) = widen16(x, y);
            }
    }
};
struct EpiF32 {
    float* dst;
    template <int MT> DEVI void operator()(f32x4 (&acc)[MT][4], int row0, int col0, int fr, int fq) const {
#pragma unroll
        for (int m = 0; m < MT; ++m) {
            __builtin_amdgcn_sched_barrier(0);
            float* rp = dst + (size_t)(row0 + 16 * m + fr) * 1024 + col0 + 4 * fq;
#pragma unroll
            for (int n = 0; n < 4; ++n) *(f32x4*)(rp + 16 * n) = acc[m][n];
        }
    }
};
struct EpiBf16 {
    bf16_t* dst;
    template <int MT> DEVI void operator()(f32x4 (&acc)[MT][4], int row0, int col0, int fr, int fq) const {
#pragma unroll
        for (int m = 0; m < MT; ++m) {
            __builtin_amdgcn_sched_barrier(0);
            bf16_t* rp = dst + (size_t)(row0 + 16 * m + fr) * 1024 + col0 + 16 * (fq & 1) + 8 * (fq >> 1);
#pragma unroll
            for (int n = 0; n < 4; n += 2) {
                uint2 x, y;
                x.x = pk2(acc[m][n][0], acc[m][n][1]); x.y = pk2(acc[m][n][2], acc[m][n][3]);
                y.x = pk2(acc[m][n + 1][0], acc[m][n + 1][1]); y.y = pk2(acc[m][n + 1][2], acc[m][n + 1][3]);
                *(uint4*)(rp + 16 * n) = widen16(x, y);
            }
        }
    }
};
struct EpiG2A {
    bf16_t *q, *kbuf, *sgate; const float *ropec, *ropes;
    template <int MT> DEVI void operator()(f32x4 (&acc)[MT][4], int row0, int col0, int fr, int fq) const {
        const int b = row0 / TPB, t0 = row0 - b * TPB;
        const bool isctx = t0 < CTX;
        if (col0 < 1280) {
            const bool isq = col0 < 1024;
            if (isq && isctx) return;
#pragma unroll
            for (int m = 0; m < MT; ++m) {
                const int t = t0 + 16 * m + fr;
                f32x4 o0 = acc[m][0], o1 = acc[m][1], o2 = acc[m][2], o3 = acc[m][3];
                if (!isctx) {
                    const int pos = t - CTX, prow = pos >> 6, pcol = pos & 63;
                    const f32x4 cr = *(const f32x4*)(ropec + prow * 16 + 4 * fq), sr = *(const f32x4*)(ropes + prow * 16 + 4 * fq);
                    const f32x4 cc = *(const f32x4*)(ropec + pcol * 16 + 4 * fq), sc = *(const f32x4*)(ropes + pcol * 16 + 4 * fq);
                    const f32x4 a0 = o0 * cr - o1 * sr, a1 = o1 * cr + o0 * sr;
                    const f32x4 a2 = o2 * cc - o3 * sc, a3 = o3 * cc + o2 * sc;
                    o0 = a0; o1 = a1; o2 = a2; o3 = a3;
                }
                bf16_t* dst;
                if (isq) {
                    const float qs = 0.125f * LOG2E;
                    o0 *= qs; o1 *= qs; o2 *= qs; o3 *= qs;
                    dst = q + (size_t)(b * SEQ + t - CTX) * 1024 + col0 + 16 * (fq & 1) + 8 * (fq >> 1);
                } else {
                    dst = kbuf + (size_t)(row0 + 16 * m + fr) * 256 + (col0 - 1024) + 16 * (fq & 1) + 8 * (fq >> 1);
                }
                uint2 x, y;
                x.x = pk2(o0[0], o0[1]); x.y = pk2(o0[2], o0[3]); y.x = pk2(o1[0], o1[1]); y.y = pk2(o1[2], o1[3]);
                *(uint4*)(dst) = widen16(x, y);
                x.x = pk2(o2[0], o2[1]); x.y = pk2(o2[2], o2[3]); y.x = pk2(o3[0], o3[1]); y.y = pk2(o3[2], o3[3]);
                *(uint4*)(dst + 32) = widen16(x, y);
            }
        } else {
            if (isctx) return;
#pragma unroll
            for (int m = 0; m < MT; ++m)
#pragma unroll
                for (int n = 0; n < 4; n += 2) {
                    const f32x4 v = acc[m][n], w_ = acc[m][n + 1];
                    uint2 x, y;
                    x.x = pk2(siluf_(v[0]), siluf_(v[1])); x.y = pk2(siluf_(v[2]), siluf_(v[3]));
                    y.x = pk2(siluf_(w_[0]), siluf_(w_[1])); y.y = pk2(siluf_(w_[2]), siluf_(w_[3]));
                    *(uint4*)(sgate + (size_t)(b * SEQ + t0 - CTX + 16 * m + fr) * 1024 + (col0 - 1280) + 16 * n + 16 * (fq & 1) + 8 * (fq >> 1)) = widen16(x, y);
                }
        }
    }
};
struct EpiG2B {
    bf16_t* vt;
    template <int MT> DEVI void operator()(f32x4 (&acc)[MT][4], int row0, int col0, int fr, int fq) const {
        const int b = row0 / TPB, t0 = row0 - b * TPB;
#pragma unroll
        for (int m = 0; m < MT; ++m)
#pragma unroll
            for (int n = 0; n < 4; ++n) {
                f32x4 v = acc[m][n];
                uint2 o; o.x = pk2(v[0], v[1]); o.y = pk2(v[2], v[3]);
                *(uint2*)(vt + ((size_t)(b * 256 + col0 + 16 * n + fr)) * TPB + t0 + 16 * m + 4 * fq) = o;
            }
    }
};

DEVI void transpose64(const float* __restrict__ src, int ld_src, bf16_t* __restrict__ dst, int ld_dst, float* sm) {
    const int tid = threadIdx.x;
    __syncthreads();
#pragma unroll
    for (int i = 0; i < 4; ++i) {
        const int k = (tid >> 4) + 16 * i, c4 = (tid & 15) * 4;
        const float4 v = *(const float4*)(src + (size_t)k * ld_src + c4);
        sm[(c4 + 0) * 65 + k] = v.x; sm[(c4 + 1) * 65 + k] = v.y; sm[(c4 + 2) * 65 + k] = v.z; sm[(c4 + 3) * 65 + k] = v.w;
    }
    __syncthreads();
#pragma unroll
    for (int i = 0; i < 2; ++i) {
        const int n = (tid >> 3) + 32 * i, k0 = (tid & 7) * 8;
        const float* s = sm + n * 65 + k0;
        uint4 o; o.x = pk2(s[0], s[1]); o.y = pk2(s[2], s[3]); o.z = pk2(s[4], s[5]); o.w = pk2(s[6], s[7]);
        *(uint4*)(dst + (size_t)n * ld_dst + k0) = o;
    }
}

DEVI void transpose_job(const P& p, int id, float* sm) {
    char* ws = p.ws;
    bf16_t* W0T = (bf16_t*)(ws + OFF_W0T); bf16_t* WO0T = (bf16_t*)(ws + OFF_WO0T);
    bf16_t* W1T = (bf16_t*)(ws + OFF_W1T); bf16_t* WO1T = (bf16_t*)(ws + OFF_WO1T); bf16_t* WG = (bf16_t*)(ws + OFF_WG);
    const float* src; int ld_src, col0, nct; bf16_t* dst; int ld_dst, drow0;
    if (id < 256) { src = p.w_in0; ld_src = 4096; col0 = 0; nct = 16; dst = W0T; ld_dst = 1024; drow0 = 0; }
    else if (id < 512) { id -= 256; src = p.w_in0; ld_src = 4096; col0 = 1024; nct = 16; dst = W0T; ld_dst = 1024; drow0 = 1024; }
    else if (id < 768) { id -= 512; src = p.w_in0; ld_src = 4096; col0 = 3072; nct = 16; dst = W0T; ld_dst = 1024; drow0 = 2048; }
    else if (id < 1280) { id -= 768; src = p.w_out0; ld_src = 1024; col0 = 0; nct = 16; dst = WO0T; ld_dst = 2048; drow0 = 0; }
    else if (id < 1536) { id -= 1280; src = p.w_in1; ld_src = 2560; col0 = 0; nct = 16; dst = W1T; ld_dst = 1024; drow0 = 0; }
    else if (id < 1600) { id -= 1536; src = p.w_in1; ld_src = 2560; col0 = 1024; nct = 4; dst = W1T; ld_dst = 1024; drow0 = 1024; }
    else if (id < 1856) { id -= 1600; src = p.w_in1; ld_src = 2560; col0 = 1536; nct = 16; dst = W1T; ld_dst = 1024; drow0 = 1280; }
    else if (id < 1920) { id -= 1856; src = p.w_in1; ld_src = 2560; col0 = 1280; nct = 4; dst = W1T; ld_dst = 1024; drow0 = 2304; }
    else if (id < 2176) { id -= 1920; src = p.w_out1; ld_src = 1024; col0 = 0; nct = 16; dst = WO1T; ld_dst = 1024; drow0 = 0; }
    else {
        id -= 2176;
        const int h = id & 15, ax = (id >> 4) & 1, dir = id >> 5;
        src = (ax ? p.w_x : p.w_a) + (size_t)(dir * 16 + h) * 4096;
        transpose64(src, 64, WG + (size_t)(h * 256 + (dir * 2 + ax) * 64) * 64, 64, sm);
        return;
    }
    const int kt = id / nct, nt = id % nct;
    transpose64(src + (size_t)(kt * 64) * ld_src + col0 + nt * 64, ld_src, dst + (size_t)(drow0 + nt * 64) * ld_dst + kt * 64, ld_dst, sm);
}

DEVI void mods_item(const P& p, int it, float* sm) {
    const int tid = threadIdx.x;
    const int layer = it / 192, col0 = (it % 192) * 16;
    const float* wmod = layer ? p.w_mod1 : p.w_mod0;
    const float* bmod = layer ? p.b_mod1 : p.b_mod0;
    float* sc = sm;
    float* red = sm + 9216;
    __syncthreads();
    for (int i = tid; i < 9216; i += 256) {
        const int r = i >> 10, k = i & 1023;
        const float v = r < 8 ? p.c[r * 1024 + k] : p.c_ctx[k];
        sc[i] = siluf_(v);
    }
    __syncthreads();
    const int col = tid & 15, kg = tid >> 4;
    float acc[9];
#pragma unroll
    for (int r = 0; r < 9; ++r) acc[r] = 0.f;
#pragma unroll
    for (int k0 = 0; k0 < 64; k0 += 32) {
        float wv[32];
#pragma unroll
        for (int u = 0; u < 32; ++u) wv[u] = wmod[(size_t)(kg * 64 + k0 + u) * 3072 + col0 + col];
#pragma unroll
        for (int u = 0; u < 32; ++u)
#pragma unroll
            for (int r = 0; r < 9; ++r) acc[r] += sc[r * 1024 + kg * 64 + k0 + u] * wv[u];
    }
#pragma unroll
    for (int r = 0; r < 9; ++r) red[(kg * 9 + r) * 16 + col] = acc[r];
    __syncthreads();
    float* mods = (float*)(p.ws + OFF_MODS);
    if (tid < 144) {
        const int r = tid >> 4, cc = tid & 15;
        float v = bmod[col0 + cc];
#pragma unroll
        for (int g = 0; g < 16; ++g) v += red[(g * 9 + r) * 16 + cc];
        mods[(size_t)(layer * 9 + r) * 3072 + col0 + cc] = v;
    }
}

DEVI void dft_row_item(const P& p, int k) {
    const int tid = threadIdx.x;
    if (k < 1024) {
        bf16_t* base = (bf16_t*)(p.ws + OFF_DL) + (size_t)k * 1024;
        const int n0 = tid * 4;
        float ce[4], co[4], se[4], so[4];
#pragma unroll
        for (int e = 0; e < 4; ++e) {
            const int n = n0 + e;
            const float fe = (float)((k * n) & 2047) * (1.0f / 2048.0f);
            const float fo = (float)(((2 * k + 1) * n) & 4095) * (1.0f / 4096.0f);
            ce[e] = __builtin_amdgcn_cosf(fe); se[e] = __builtin_amdgcn_sinf(fe);
            co[e] = __builtin_amdgcn_cosf(fo); so[e] = __builtin_amdgcn_sinf(fo);
        }
        uint2 o;
        o.x = pk2(ce[0], ce[1]); o.y = pk2(ce[2], ce[3]); *(uint2*)(base + n0) = o;
        o.x = pk2(co[0], co[1]); o.y = pk2(co[2], co[3]); *(uint2*)(base + 1048576 + n0) = o;
        o.x = pk2(se[0], se[1]); o.y = pk2(se[2], se[3]); *(uint2*)(base + 2 * 1048576 + n0) = o;
        o.x = pk2(so[0], so[1]); o.y = pk2(so[2], so[3]); *(uint2*)(base + 3 * 1048576 + n0) = o;
    } else {
        const int kk = k - 1024;
        bf16_t* dc = (bf16_t*)(p.ws + OFF_DC) + (size_t)kk * 512;
        if (tid < 64) {
            const int n0 = tid * 8;
            float v[8];
#pragma unroll
            for (int e = 0; e < 8; ++e) {
                const int ci = n0 + e, n = ci & 255;
                const float fr_ = (float)((kk * n) & 255) * (1.0f / 256.0f);
                v[e] = ci < 256 ? __builtin_amdgcn_cosf(fr_) : -__builtin_amdgcn_sinf(fr_);
            }
            uint4 o; o.x = pk2(v[0], v[1]); o.y = pk2(v[2], v[3]); o.z = pk2(v[4], v[5]); o.w = pk2(v[6], v[7]);
            *(uint4*)(dc + n0) = o;
        }
    }
}

DEVI void wcs_item(const P& p, int it) {
    const int tid = threadIdx.x;
    const int g = it >> 6, d = (it & 63) * 2 + (tid >> 7), e = tid & 127;
    float ac = 0.f, as = 0.f;
#pragma unroll 1
    for (int l0 = 0; l0 < 128; l0 += 32) {
        float wv[32];
#pragma unroll
        for (int u = 0; u < 32; ++u) wv[u] = p.w_f[(size_t)(g * 128 + l0 + u) * 128 + e];
#pragma unroll
        for (int u = 0; u < 32; ++u) {
            const float fr_ = (float)(((l0 + u) * d) & 127) * (1.0f / 128.0f);
            ac += __builtin_amdgcn_cosf(fr_) * wv[u];
            as += __builtin_amdgcn_sinf(fr_) * wv[u];
        }
    }
    float* wc = (float*)(p.ws + OFF_WCS);
    wc[(size_t)(g * 128 + d) * 128 + e] = ac;
    wc[131072 + (size_t)(g * 128 + d) * 128 + e] = as;
}

DEVI void rope_item(const P& p) {
    float* rc = (float*)(p.ws + OFF_ROPE);
    for (int i = threadIdx.x; i < 1024; i += 256) {
        const int pos = i >> 4, j = i & 15;
        const float freq = powf(10000.0f, -(float)(2 * j) / 32.0f);
        const float ang = (float)pos * freq;
        rc[i] = cosf(ang);
        rc[1024 + i] = sinf(ang);
    }
}

DEVI void compose_item(const P& p, int it, float* sm) {
    const int tid = threadIdx.x;
    const int g = it >> 5, j0 = (it & 31) * 32;
    __syncthreads();
#pragma unroll
    for (int i = 0; i < 4; ++i) {
        const int row = (tid >> 5) + 8 * i, c4 = (tid & 31) * 4;
        *(float4*)(sm + row * 128 + c4) = *(const float4*)(p.w_in0 + (size_t)(j0 + row) * 4096 + 2048 + 128 * g + c4);
    }
    __syncthreads();
    const int e = tid & 127, half = tid >> 7;
    const float* wc = (const float*)(p.ws + OFF_WCS) + (size_t)g * 16384 + e;
    const float* wsn = wc + 131072;
    float ap[16], aq[16];
#pragma unroll
    for (int jj = 0; jj < 16; ++jj) { ap[jj] = 0.f; aq[jj] = 0.f; }
#pragma unroll 1
    for (int d0 = 0; d0 < 128; d0 += 16) {
        float cw[16], sw[16];
#pragma unroll
        for (int u = 0; u < 16; ++u) { cw[u] = wc[(d0 + u) * 128]; sw[u] = wsn[(d0 + u) * 128]; }
#pragma unroll
        for (int jj = 0; jj < 16; ++jj) {
#pragma unroll
            for (int u = 0; u < 16; u += 4) {
                const f32x4 v = *(const f32x4*)(sm + (half * 16 + jj) * 128 + d0 + u);
                ap[jj] += v[0] * cw[u] + v[1] * cw[u + 1] + v[2] * cw[u + 2] + v[3] * cw[u + 3];
                aq[jj] += v[0] * sw[u] + v[1] * sw[u + 1] + v[2] * sw[u + 2] + v[3] * sw[u + 3];
            }
        }
    }
    bf16_t* W0T = (bf16_t*)(p.ws + OFF_W0T);
    bf16_t* dp = W0T + (size_t)(3072 + g * 128 + e) * 1024 + j0 + half * 16;
    bf16_t* dq = W0T + (size_t)(4096 + g * 128 + e) * 1024 + j0 + half * 16;
    uint4 o;
    o.x = pk2(ap[0], ap[1]); o.y = pk2(ap[2], ap[3]); o.z = pk2(ap[4], ap[5]); o.w = pk2(ap[6], ap[7]); *(uint4*)dp = o;
    o.x = pk2(ap[8], ap[9]); o.y = pk2(ap[10], ap[11]); o.z = pk2(ap[12], ap[13]); o.w = pk2(ap[14], ap[15]); *(uint4*)(dp + 8) = o;
    o.x = pk2(aq[0], aq[1]); o.y = pk2(aq[2], aq[3]); o.z = pk2(aq[4], aq[5]); o.w = pk2(aq[6], aq[7]); *(uint4*)dq = o;
    o.x = pk2(aq[8], aq[9]); o.y = pk2(aq[10], aq[11]); o.z = pk2(aq[12], aq[13]); o.w = pk2(aq[14], aq[15]); *(uint4*)(dq + 8) = o;
}

DEVI float sumsq4(const f32x4& v) { return v[0] * v[0] + v[1] * v[1] + v[2] * v[2] + v[3] * v[3]; }
DEVI void h0_rows(const P& p, int it) {
    const int lane = threadIdx.x & 63, w = threadIdx.x >> 6;
    int r[2], b[2], t[2]; const float* src[2]; const float* mod[2];
#pragma unroll
    for (int q = 0; q < 2; ++q) {
        r[q] = it * 8 + w + 4 * q; b[q] = r[q] / TPB; t[q] = r[q] - b[q] * TPB;
        src[q] = t[q] < CTX ? p.ctx + (size_t)(b[q] * CTX + t[q]) * 1024 : p.x + (size_t)(b[q] * SEQ + t[q] - CTX) * 1024;
        mod[q] = (const float*)(p.ws + OFF_MODS) + (size_t)(t[q] < CTX ? 8 : b[q]) * 3072;
    }
    f32x4 v[2][4];
    float ss[2] = {0.f, 0.f};
#pragma unroll
    for (int q = 0; q < 2; ++q)
#pragma unroll
        for (int i = 0; i < 4; ++i) v[q][i] = *(const f32x4*)(src[q] + (i * 64 + lane) * 4);
#pragma unroll
    for (int q = 0; q < 2; ++q) {
#pragma unroll
        for (int i = 0; i < 4; ++i) ss[q] += sumsq4(v[q][i]);
        ss[q] = wave_sum(ss[q]);
    }
#pragma unroll
    for (int q = 0; q < 2; ++q) {
        const float rstd = rsqrtf(ss[q] * (1.0f / 1024.0f) + 1e-6f);
        bf16_t* hb = (bf16_t*)(p.ws + OFF_A) + (size_t)r[q] * 1024;
#pragma unroll
        for (int i = 0; i < 4; ++i) {
            const int col = (i * 64 + lane) * 4;
            const f32x4 g = *(const f32x4*)(p.g_pre0 + col), sh = *(const f32x4*)(mod[q] + col), sc = *(const f32x4*)(mod[q] + 1024 + col);
            const f32x4 h = (v[q][i] * rstd * g) * (sc + 1.0f) + sh;
            uint2 o; o.x = pk2(h[0], h[1]); o.y = pk2(h[2], h[3]);
            *(uint2*)(hb + col) = o;
        }
    }
}

DEVI void norm1_rows(const P& p, int it) {
    const int lane = threadIdx.x & 63, w = threadIdx.x >> 6;
    int r[2], b[2], t[2]; const float* src[2]; const float* mod0[2];
#pragma unroll
    for (int q = 0; q < 2; ++q) {
        r[q] = it * 8 + w + 4 * q; b[q] = r[q] / TPB; t[q] = r[q] - b[q] * TPB;
        src[q] = t[q] < CTX ? p.ctx + (size_t)(b[q] * CTX + t[q]) * 1024 : p.x + (size_t)(b[q] * SEQ + t[q] - CTX) * 1024;
        mod0[q] = (const float*)(p.ws + OFF_MODS) + (size_t)(t[q] < CTX ? 8 : b[q]) * 3072;
    }
    f32x4 v[2][4], xs[2][4];
    float ss[2] = {0.f, 0.f};
#pragma unroll
    for (int q = 0; q < 2; ++q) {
        const bf16_t* y = (const bf16_t*)(p.ws + OFF_E) + (size_t)r[q] * 1024;
#pragma unroll
        for (int i = 0; i < 4; ++i) {
            const uint2 q_ = *(const uint2*)(y + (i * 64 + lane) * 4);
            v[q][i] = (f32x4){bflo(q_.x), bfhi(q_.x), bflo(q_.y), bfhi(q_.y)};
            xs[q][i] = *(const f32x4*)(src[q] + (i * 64 + lane) * 4);
        }
    }
#pragma unroll
    for (int q = 0; q < 2; ++q) {
#pragma unroll
        for (int i = 0; i < 4; ++i) ss[q] += sumsq4(v[q][i]);
        ss[q] = wave_sum(ss[q]);
    }
    float ss2[2] = {0.f, 0.f};
#pragma unroll
    for (int q = 0; q < 2; ++q) {
        const float rstd = rsqrtf(ss[q] * (1.0f / 1024.0f) + 1e-6f);
#pragma unroll
        for (int i = 0; i < 4; ++i) {
            const int col = (i * 64 + lane) * 4;
            const f32x4 g = *(const f32x4*)(p.g_post0 + col), gt = *(const f32x4*)(mod0[q] + 2048 + col);
            v[q][i] = xs[q][i] + gt * (v[q][i] * rstd * g);
            ss2[q] += sumsq4(v[q][i]);
            if (t[q] >= CTX) *(f32x4*)(p.out + (size_t)(b[q] * SEQ + t[q] - CTX) * 1024 + col) = v[q][i];
        }
        ss2[q] = wave_sum(ss2[q]);
    }
#pragma unroll
    for (int q = 0; q < 2; ++q) {
        const float rstd2 = rsqrtf(ss2[q] * (1.0f / 1024.0f) + 1e-6f);
        const float* mod1 = mod0[q] + 9 * 3072;
        bf16_t* hb = (bf16_t*)(p.ws + OFF_A) + (size_t)r[q] * 1024;
#pragma unroll
        for (int i = 0; i < 4; ++i) {
            const int col = (i * 64 + lane) * 4;
            const f32x4 g = *(const f32x4*)(p.g_pre1 + col), sh = *(const f32x4*)(mod1 + col), sc = *(const f32x4*)(mod1 + 1024 + col);
            const f32x4 h = (v[q][i] * rstd2 * g) * (sc + 1.0f) + sh;
            uint2 o; o.x = pk2(h[0], h[1]); o.y = pk2(h[2], h[3]);
            *(uint2*)(hb + col) = o;
        }
    }
}

DEVI void final_rows(const P& p, int it) {
    const int lane = threadIdx.x & 63, w = threadIdx.x >> 6;
    f32x4 v[2][4], xs[2][4];
    float ss[2] = {0.f, 0.f};
#pragma unroll
    for (int q = 0; q < 2; ++q) {
        const int r = it * 8 + w + 4 * q;
        const bf16_t* y = (const bf16_t*)(p.ws + OFF_E) + (size_t)r * 1024;
        const float* o = p.out + (size_t)r * 1024;
#pragma unroll
        for (int i = 0; i < 4; ++i) {
            const uint2 q_ = *(const uint2*)(y + (i * 64 + lane) * 4);
            v[q][i] = (f32x4){bflo(q_.x), bfhi(q_.x), bflo(q_.y), bfhi(q_.y)};
            xs[q][i] = *(const f32x4*)(o + (i * 64 + lane) * 4);
        }
    }
#pragma unroll
    for (int q = 0; q < 2; ++q) {
#pragma unroll
        for (int i = 0; i < 4; ++i) ss[q] += sumsq4(v[q][i]);
        ss[q] = wave_sum(ss[q]);
    }
#pragma unroll
    for (int q = 0; q < 2; ++q) {
        const int r = it * 8 + w + 4 * q, b = r >> 12;
        const float* mod1 = (const float*)(p.ws + OFF_MODS) + (size_t)(9 + b) * 3072;
        float* o = p.out + (size_t)r * 1024;
        const float rstd = rsqrtf(ss[q] * (1.0f / 1024.0f) + 1e-6f);
#pragma unroll
        for (int i = 0; i < 4; ++i) {
            const int col = (i * 64 + lane) * 4;
            const f32x4 g = *(const f32x4*)(p.g_post1 + col), gt = *(const f32x4*)(mod1 + 2048 + col);
            *(f32x4*)(o + col) = xs[q][i] + gt * (v[q][i] * rstd * g);
        }
    }
}

constexpr size_t OFF_PS1024 = 510 * MiB;
constexpr size_t OFF_QS1024 = 510 * MiB + 64 * 1024;
constexpr size_t OFF_HPART = 510 * MiB + 256 * 1024;
constexpr size_t OFF_HS = 510 * MiB + 1024 * 1024;
constexpr size_t OFF_HF = OFF_E;
constexpr size_t OFF_T = OFF_E;
constexpr size_t OFF_PE = OFF_E + 64 * MiB;
DEVI float bfe(const uint4& q, int i) { const unsigned wd = (i >> 1) == 0 ? q.x : ((i >> 1) == 1 ? q.y : ((i >> 1) == 2 ? q.z : q.w)); return (i & 1) ? bfhi(wd) : bflo(wd); }
DEVI void hfold_item(const P& p, int it, float* sm) {
    const int tid = threadIdx.x, lane = tid & 63, w = tid >> 6;
    const int b = it >> 4, nb = it & 15;
    const bf16_t* H = (const bf16_t*)(p.ws + OFF_A) + (size_t)(b * TPB + CTX) * 1024;
    bf16_t* HF = (bf16_t*)(p.ws + OFF_HF) + (size_t)b * 4 * 1048576;
    float alt[16];
#pragma unroll
    for (int c = 0; c < 16; ++c) alt[c] = 0.f;
    for (int k = 0; k < 16; ++k) {
        const int n = nb * 64 + w * 16 + k;
        const float sgn = (n & 1) ? -1.0f : 1.0f;
        const int nB = n == 0 ? 0 : 4096 - n;
#pragma unroll
        for (int i = 0; i < 2; ++i) {
            const int j0 = (i * 64 + lane) * 8;
            const uint4 qa = *(const uint4*)(H + (size_t)n * 1024 + j0), qb = *(const uint4*)(H + (size_t)nB * 1024 + j0);
            const uint4 qc = *(const uint4*)(H + (size_t)(2048 - n) * 1024 + j0), qd = *(const uint4*)(H + (size_t)(2048 + n) * 1024 + j0);
            float he[8], ho[8], hqe[8], hqo[8];
#pragma unroll
            for (int c = 0; c < 8; ++c) {
                const float A = bfe(qa, c), C = bfe(qc, c);
                const float B = n == 0 ? 0.f : bfe(qb, c), D = n == 0 ? 0.f : bfe(qd, c);
                he[c] = (A + B) + (C + D); ho[c] = (A + B) - (C + D);
                hqe[c] = n == 0 ? 0.f : (A - B) - (C - D); hqo[c] = n == 0 ? 0.f : (A - B) + (C - D);
                alt[i * 8 + c] += sgn * he[c];
            }
            uint4 o;
            o.x = pk2(he[0], he[1]); o.y = pk2(he[2], he[3]); o.z = pk2(he[4], he[5]); o.w = pk2(he[6], he[7]);
            *(uint4*)(HF + (size_t)n * 1024 + j0) = o;
            o.x = pk2(ho[0], ho[1]); o.y = pk2(ho[2], ho[3]); o.z = pk2(ho[4], ho[5]); o.w = pk2(ho[6], ho[7]);
            *(uint4*)(HF + 1048576 + (size_t)n * 1024 + j0) = o;
            o.x = pk2(hqe[0], hqe[1]); o.y = pk2(hqe[2], hqe[3]); o.z = pk2(hqe[4], hqe[5]); o.w = pk2(hqe[6], hqe[7]);
            *(uint4*)(HF + 2 * 1048576 + (size_t)n * 1024 + j0) = o;
            o.x = pk2(hqo[0], hqo[1]); o.y = pk2(hqo[2], hqo[3]); o.z = pk2(hqo[4], hqo[5]); o.w = pk2(hqo[6], hqo[7]);
            *(uint4*)(HF + 3 * 1048576 + (size_t)n * 1024 + j0) = o;
        }
    }
    __syncthreads();
#pragma unroll
    for (int i = 0; i < 2; ++i)
#pragma unroll
        for (int c = 0; c < 8; ++c) sm[w * 1024 + (i * 64 + lane) * 8 + c] = alt[i * 8 + c];
    __syncthreads();
    float* hp = (float*)(p.ws + OFF_HPART) + (size_t)it * 1024;
#pragma unroll
    for (int c = 0; c < 4; ++c) { const int j = tid * 4 + c; hp[j] = sm[j] + sm[1024 + j] + sm[2048 + j] + sm[3072 + j]; }
    if (nb == 0) {
        float* hs = (float*)(p.ws + OFF_HS) + (size_t)b * 2048;
#pragma unroll
        for (int c = 0; c < 4; ++c) {
            const int j = tid * 4 + c;
            const float h1 = bf2f(H[(size_t)1024 * 1024 + j]), h3 = bf2f(H[(size_t)3072 * 1024 + j]);
            hs[j] = h1 + h3; hs[1024 + j] = h1 - h3;
        }
    }
}

DEVI void fspecial_item(const P& p, int it, float* sm) {
    const int tid = threadIdx.x;
    const int b = it >> 6, e0 = (it & 63) * 16;
    const float* hs = (const float*)(p.ws + OFF_HS) + (size_t)b * 2048;
    const float* part = (const float*)(p.ws + OFF_HPART) + (size_t)b * 16 * 1024;
    __syncthreads();
#pragma unroll
    for (int c = 0; c < 4; ++c) {
        const int j = tid * 4 + c;
        const float hpv = hs[j], hqv = hs[1024 + j];
        float a = hpv;
#pragma unroll
        for (int q = 0; q < 16; ++q) a += part[q * 1024 + j];
        sm[j] = a; sm[1024 + j] = hpv; sm[2048 + j] = hqv;
    }
    __syncthreads();
    const int e = e0 + (tid >> 4), jp = tid & 15;
    const bf16_t* wp = (const bf16_t*)(p.ws + OFF_W0T) + (size_t)(3072 + e) * 1024 + jp * 64;
    const bf16_t* wq = (const bf16_t*)(p.ws + OFF_W0T) + (size_t)(4096 + e) * 1024 + jp * 64;
    float y = 0.f, ps = 0.f, qs = 0.f;
#pragma unroll
    for (int v8 = 0; v8 < 8; ++v8) {
        const uint4 a = *(const uint4*)(wp + v8 * 8), q = *(const uint4*)(wq + v8 * 8);
#pragma unroll
        for (int c = 0; c < 8; ++c) {
            const int j = jp * 64 + v8 * 8 + c;
            const float wa = bfe(a, c), wb = bfe(q, c);
            y += sm[j] * wa; ps += sm[1024 + j] * wa; qs += sm[2048 + j] * wb;
        }
    }
#pragma unroll
    for (int o = 8; o > 0; o >>= 1) { y += __shfl_xor(y, o); ps += __shfl_xor(ps, o); qs += __shfl_xor(qs, o); }
    if (jp == 0) {
        ((float*)(p.ws + OFF_PS1024))[b * 1024 + e] = ps;
        ((float*)(p.ws + OFF_QS1024))[b * 1024 + e] = qs;
        bf16_t* ptr = (bf16_t*)(p.ws + OFF_D) + (size_t)(b * TPB + CTX + 2048) * 1024 + e;
        const float v = (y * 0.0013810679320049757f + p.b_f[e]) * bf2f(*ptr);
        *ptr = (bf16_t)(pk2(v, 0.f) & 0xffffu);
    }
}

constexpr size_t OFF_CIN = OFF_AGG + 9 * MiB;
DEVI void lru_preload(const P& p, int h, char* smem) {
    const int tid = threadIdx.x;
    const bf16_t* WG = (const bf16_t*)(p.ws + OFF_WG) + (size_t)h * 256 * 64;
    float* prm = (float*)(smem + 32768);
    __syncthreads();
#pragma unroll
    for (int i = 0; i < 8; ++i) {
        const int row = (tid >> 3) + 32 * i, ch = tid & 7;
        *(uint4*)(smem + row * 128 + ((ch ^ (row & 7)) << 4)) = *(const uint4*)(WG + (size_t)row * 64 + ch * 8);
    }
    if (tid < 64) {
        const int gch = h * 64 + tid;
#pragma unroll
        for (int k = 0; k < 4; ++k) prm[k * 64 + tid] = p.w_conv[k * 1024 + gch];
        prm[4 * 64 + tid] = p.b_conv[gch];
#pragma unroll
        for (int d = 0; d < 2; ++d) {
            prm[(5 + d) * 64 + tid] = -LOG2E * p.b_a[d * 1024 + gch];
            prm[(7 + d) * 64 + tid] = -LOG2E * p.b_x[d * 1024 + gch];
            const float lm = p.lam[d * 1024 + gch];
            prm[(9 + d) * 64 + tid] = -8.0f * LOG2E * (fmaxf(-lm, 0.f) + log1pf(__expf(-fabsf(lm))));
        }
    }
    __syncthreads();
}

DEVI void lru_load_us(const P& p, int item, int tid, uint4& u0, uint4& u1, uint4& u2) {
    const int h = item & 15, c = (item >> 4) % NCH, b = item / (16 * NCH);
    const int tb = c * 64, seg_lo = c < 4 ? 0 : CTX, seg_hi = c < 4 ? CTX : TPB;
    const bf16_t* U = (const bf16_t*)(p.ws + OFF_B) + (size_t)b * TPB * 1024 + h * 64 + (tid & 7) * 8;
    const uint4 z = {0u, 0u, 0u, 0u};
    const int t0 = tb - 2 + (tid >> 3), t1 = t0 + 32, t2 = t0 + 64;
    u0 = (t0 >= seg_lo && t0 < seg_hi) ? *(const uint4*)(U + (size_t)t0 * 1024) : z;
    u1 = (t1 >= seg_lo && t1 < seg_hi) ? *(const uint4*)(U + (size_t)t1 * 1024) : z;
    u2 = (tid < 24 && t2 >= seg_lo && t2 < seg_hi) ? *(const uint4*)(U + (size_t)t2 * 1024) : z;
}
template <bool PASS_C>
DEVI void lru_item(const P& p, int item, int next_item, uint4& u0, uint4& u1, uint4& u2, float& cpre, char* smem) {
    const int tid = threadIdx.x, lane = tid & 63, w = tid >> 6, fr = lane & 15, fq = lane >> 4;
    const int h = item & 15, c = (item >> 4) % NCH, b = item / (16 * NCH);
    const float* prm = (const float*)(smem + 32768);
    bf16_t* us = (bf16_t*)(smem + 35840);
    char* ucb = smem + 35840 + 8704;
    float* ytile = (float*)(smem + 35840);
    float* wagg = (float*)(smem + 52736);
    float* carry = (float*)(smem + 56832);
    float2* agg = (float2*)(p.ws + OFF_AGG);
    const int tb = c * 64;
    const size_t rbase = (size_t)b * TPB;
    __syncthreads();
    *(uint4*)(us + tid * 8) = u0;
    *(uint4*)(us + (tid + 256) * 8) = u1;
    if (tid < 24) *(uint4*)(us + (tid + 512) * 8) = u2;
    if (PASS_C && tid < 128) carry[tid] = cpre;
    uint4 sg0 = {0u, 0u, 0u, 0u}, sg1 = {0u, 0u, 0u, 0u};
    if (PASS_C) {
        const bf16_t* SG = (const bf16_t*)(p.ws + OFF_C) + (rbase + tb + (tid >> 2)) * 1024 + h * 64 + (tid & 3) * 16;
        sg0 = *(const uint4*)(SG); sg1 = *(const uint4*)(SG + 8);
    }
    if (next_item >= 0) {
        lru_load_us(p, next_item, tid, u0, u1, u2);
        if (PASS_C && tid < 128) {
            const int nh = next_item & 15, nc = (next_item >> 4) % NCH, nb = next_item / (16 * NCH);
            cpre = ((const float*)(p.ws + OFF_CIN))[(size_t)(nb * NCH + nc) * 2048 + (tid >> 6) * 1024 + nh * 64 + (tid & 63)];
        }
    }
    __syncthreads();
    {
        const int tok = tid >> 2, cg0 = (tid & 3) * 16;
        uint4 r[4][2];
#pragma unroll
        for (int k = 0; k < 4; ++k) { r[k][0] = *(const uint4*)(us + (tok + k) * 64 + cg0); r[k][1] = *(const uint4*)(us + (tok + k) * 64 + cg0 + 8); }
        float val[16];
#pragma unroll
        for (int e = 0; e < 16; ++e) {
            const int ch = cg0 + e;
            float a = prm[4 * 64 + ch];
#pragma unroll
            for (int k = 0; k < 4; ++k) {
                const uint4 q = r[k][e >> 3];
                const unsigned wd = ((e >> 1) & 3) == 0 ? q.x : (((e >> 1) & 3) == 1 ? q.y : (((e >> 1) & 3) == 2 ? q.z : q.w));
                a += prm[k * 64 + ch] * ((e & 1) ? bfhi(wd) : bflo(wd));
            }
            val[e] = a;
        }
        uint4 o;
        o.x = pk2(val[0], val[1]); o.y = pk2(val[2], val[3]); o.z = pk2(val[4], val[5]); o.w = pk2(val[6], val[7]);
        *(uint4*)(ucb + tok * 128 + ((((cg0 >> 3) + 0) ^ (tok & 7)) << 4)) = o;
        o.x = pk2(val[8], val[9]); o.y = pk2(val[10], val[11]); o.z = pk2(val[12], val[13]); o.w = pk2(val[14], val[15]);
        *(uint4*)(ucb + tok * 128 + ((((cg0 >> 3) + 1) ^ (tok & 7)) << 4)) = o;
    }
    __syncthreads();
    f32x4 acc[16];
#pragma unroll
    for (int n = 0; n < 16; ++n) acc[n] = (f32x4){0.f, 0.f, 0.f, 0.f};
    {
        bf16x8 af[2];
#pragma unroll
        for (int kk = 0; kk < 2; ++kk) af[kk] = *(const bf16x8*)(ucb + (16 * w + fr) * 128 + (((kk * 4 + fq) ^ (fr & 7)) << 4));
#pragma unroll
        for (int n = 0; n < 16; ++n)
#pragma unroll
            for (int kk = 0; kk < 2; ++kk) {
                const bf16x8 bfr = *(const bf16x8*)(smem + (16 * n + fr) * 128 + (((kk * 4 + fq) ^ (fr & 7)) << 4));
                acc[n] = __builtin_amdgcn_mfma_f32_16x16x32_bf16(af[kk], bfr, acc[n], 0, 0, 0);
            }
    }
    float av[4][2][4], bv[4][2][4], apre[4][2], bpre[4][2];
#pragma unroll
    for (int nn = 0; nn < 4; ++nn) {
        const int ch = 16 * nn + fr;
        float uc[4];
#pragma unroll
        for (int j = 0; j < 4; ++j) {
            const int tl = 16 * w + 4 * fq + j;
            uc[j] = bf2f(*(const bf16_t*)(ucb + tl * 128 + ((((ch >> 3)) ^ (tl & 7)) << 4) + (ch & 7) * 2));
        }
#pragma unroll
        for (int d = 0; d < 2; ++d) {
            const float ba = prm[(5 + d) * 64 + ch], bx = prm[(7 + d) * 64 + ch], nsp8 = prm[(9 + d) * 64 + ch];
#pragma unroll
            for (int j = 0; j < 4; ++j) {
                const float r = __builtin_amdgcn_rcpf(1.0f + __builtin_amdgcn_exp2f(__builtin_fmaf(acc[(2 * d) * 4 + nn][j], -LOG2E, ba)));
                const float ig = __builtin_amdgcn_rcpf(1.0f + __builtin_amdgcn_exp2f(__builtin_fmaf(acc[(2 * d + 1) * 4 + nn][j], -LOG2E, bx)));
                const float a_ = __builtin_amdgcn_exp2f(nsp8 * r);
                av[nn][d][j] = a_;
                bv[nn][d][j] = __builtin_amdgcn_sqrtf(__builtin_fmaf(-a_, a_, 1.0f)) * ig * uc[j];
            }
            float A = 1.f, Bq = 0.f;
            if (d == 0) {
#pragma unroll
                for (int j = 0; j < 4; ++j) { Bq = av[nn][d][j] * Bq + bv[nn][d][j]; A *= av[nn][d][j]; }
            } else {
#pragma unroll
                for (int j = 3; j >= 0; --j) { Bq = av[nn][d][j] * Bq + bv[nn][d][j]; A *= av[nn][d][j]; }
            }
            float Ag[4], Bg[4];
            rowgather4(A, Ag); rowgather4(Bq, Bg);
            float AW = 1.f, BW = 0.f, AP = 1.f, BP = 0.f;
            if (d == 0) {
#pragma unroll
                for (int g = 0; g < 4; ++g) {
                    if (g == fq) { AP = AW; BP = BW; }
                    BW = Ag[g] * BW + Bg[g]; AW *= Ag[g];
                }
            } else {
#pragma unroll
                for (int g = 3; g >= 0; --g) {
                    if (g == fq) { AP = AW; BP = BW; }
                    BW = Ag[g] * BW + Bg[g]; AW *= Ag[g];
                }
            }
            apre[nn][d] = AP; bpre[nn][d] = BP;
            if (fq == 0) { wagg[((w * 2 + d) * 64 + ch) * 2 + 0] = AW; wagg[((w * 2 + d) * 64 + ch) * 2 + 1] = BW; }
        }
    }
    __syncthreads();
    if (!PASS_C) {
        if (tid < 128) {
            const int d = tid >> 6, ch = tid & 63;
            float A = 1.f, Bq = 0.f;
            if (d == 0) {
#pragma unroll
                for (int ww = 0; ww < 4; ++ww) { const float a_ = wagg[((ww * 2 + d) * 64 + ch) * 2], b_ = wagg[((ww * 2 + d) * 64 + ch) * 2 + 1]; Bq = a_ * Bq + b_; A *= a_; }
            } else {
#pragma unroll
                for (int ww = 3; ww >= 0; --ww) { const float a_ = wagg[((ww * 2 + d) * 64 + ch) * 2], b_ = wagg[((ww * 2 + d) * 64 + ch) * 2 + 1]; Bq = a_ * Bq + b_; A *= a_; }
            }
            agg[(size_t)(b * NCH + c) * 2048 + d * 1024 + h * 64 + ch] = make_float2(A, Bq);
        }
    } else {
#pragma unroll
        for (int nn = 0; nn < 4; ++nn) {
            const int ch = 16 * nn + fr;
            float y[4];
            {
                float hw = carry[ch];
#pragma unroll
                for (int ww = 0; ww < 4; ++ww)
                    if (ww < w) hw = wagg[((ww * 2 + 0) * 64 + ch) * 2] * hw + wagg[((ww * 2 + 0) * 64 + ch) * 2 + 1];
                float hh = apre[nn][0] * hw + bpre[nn][0];
#pragma unroll
                for (int j = 0; j < 4; ++j) { hh = av[nn][0][j] * hh + bv[nn][0][j]; y[j] = hh; }
            }
            {
                float hw = carry[64 + ch];
#pragma unroll
                for (int ww = 3; ww >= 0; --ww)
                    if (ww > w) hw = wagg[((ww * 2 + 1) * 64 + ch) * 2] * hw + wagg[((ww * 2 + 1) * 64 + ch) * 2 + 1];
                float hh = apre[nn][1] * hw + bpre[nn][1];
#pragma unroll
                for (int j = 3; j >= 0; --j) { hh = av[nn][1][j] * hh + bv[nn][1][j]; y[j] += hh; }
            }
#pragma unroll
            for (int j = 0; j < 4; ++j) ytile[(16 * w + 4 * fq + j) * 66 + ch] = y[j];
        }
        __syncthreads();
        {
            const int tok = tid >> 2, cg0 = (tid & 3) * 16;
            bf16_t* MX = (bf16_t*)(p.ws + OFF_A) + (rbase + tb + tok) * 1024 + h * 64 + cg0;
#pragma unroll
            for (int i = 0; i < 2; ++i) {
                const uint4 s = i ? sg1 : sg0;
                const float* yy = ytile + tok * 66 + cg0 + 8 * i;
                uint4 o;
                o.x = pk2(yy[0] * bflo(s.x), yy[1] * bfhi(s.x)); o.y = pk2(yy[2] * bflo(s.y), yy[3] * bfhi(s.y));
                o.z = pk2(yy[4] * bflo(s.z), yy[5] * bfhi(s.z)); o.w = pk2(yy[6] * bflo(s.w), yy[7] * bfhi(s.w));
                *(uint4*)(MX + 8 * i) = o;
            }
        }
    }
}

DEVI void lru_carry_item(const P& p, int it) {
    const int gid = it * 256 + threadIdx.x, b = gid >> 11, d = (gid >> 10) & 1, ch = gid & 1023;
    const float2* ab = (const float2*)(p.ws + OFF_AGG) + (size_t)(b * NCH) * 2048 + d * 1024 + ch;
    float* cin = (float*)(p.ws + OFF_CIN) + (size_t)(b * NCH) * 2048 + d * 1024 + ch;
    float hh = 0.f;
    for (int s0 = 0; s0 < NCH; s0 += 17) {
        float2 v[17];
#pragma unroll
        for (int u_ = 0; u_ < 17; ++u_) { const int i = s0 + u_; const int cc = d == 0 ? i : (i < 4 ? 3 - i : 71 - i); v[u_] = ab[(size_t)cc * 2048]; }
#pragma unroll
        for (int u_ = 0; u_ < 17; ++u_) { const int i = s0 + u_; const int cc = d == 0 ? i : (i < 4 ? 3 - i : 71 - i); cin[(size_t)cc * 2048] = hh; hh = v[u_].x * hh + v[u_].y; }
    }
}

DEVI void attn_item(const P& p, int item, char* smem) {
    const int tid = threadIdx.x, lane = tid & 63, w = tid >> 6, fr = lane & 15, fq = lane >> 4;
    const int qt = item & 63, kvh = (item >> 6) & 3, b = item >> 8;
    const int head = kvh * 4 + w, q0 = qt * 64;
    const bf16_t* Q = (const bf16_t*)(p.ws + OFF_B) + ((size_t)(b * SEQ + q0)) * 1024 + head * 64;
    const bf16_t* KB = (const bf16_t*)(p.ws + OFF_D);
    const bf16_t* VT = (const bf16_t*)(p.ws + OFF_D + 17 * MiB);
    char* sK = smem;
    char* sV = smem + 8192;
    const float sinkv = p.sink[head] * LOG2E;
    const bf16_t* SGT = (const bf16_t*)(p.ws + OFF_C) + ((size_t)(b * SEQ + q0)) * 1024 + head * 64;
    bf16_t* OG = (bf16_t*)(p.ws + OFF_A) + ((size_t)(b * SEQ + q0)) * 1024 + head * 64;
#pragma unroll 1
    for (int mh = 0; mh < 2; ++mh) {
        const int mo = mh * 32;
        bf16x8 Qf[2][2];
#pragma unroll
        for (int m = 0; m < 2; ++m)
#pragma unroll
            for (int kk = 0; kk < 2; ++kk) Qf[m][kk] = *(const bf16x8*)(Q + (size_t)(mo + 16 * m + fr) * 1024 + kk * 32 + fq * 8);
        f32x4 O[4][2];
#pragma unroll
        for (int nd = 0; nd < 4; ++nd)
#pragma unroll
            for (int m = 0; m < 2; ++m) O[nd][m] = (f32x4){0.f, 0.f, 0.f, 0.f};
        float mrow[2], lrow[2];
#pragma unroll
        for (int m = 0; m < 2; ++m) { mrow[m] = sinkv; lrow[m] = (fq == 0) ? 1.0f : 0.0f; }

        for (int ti = 0; ti < 9; ++ti) {
            int tok0; bool lat;
            if (ti < 5) { const int kb = q0 - 128 + 64 * ti; if (kb < 0 || kb >= SEQ) continue; tok0 = CTX + kb; lat = true; }
            else { tok0 = (ti - 5) * 64; lat = false; }
            __syncthreads();
#pragma unroll
            for (int i = 0; i < 2; ++i) {
                const int row = (tid >> 3) + 32 * i, ch = tid & 7;
                const uint4 kv = *(const uint4*)(KB + ((size_t)(b * TPB + tok0 + row)) * 256 + kvh * 64 + ch * 8);
                *(uint4*)(sK + row * 128 + ((ch ^ (row & 7)) << 4)) = kv;
                const uint4 vv = *(const uint4*)(VT + ((size_t)(b * 256 + kvh * 64 + row)) * TPB + tok0 + ch * 8);
                *(uint4*)(sV + row * 128 + ((ch ^ ((row >> 1) & 7)) << 4)) = vv;
            }
            __syncthreads();
            bf16x8 Kf[4][2];
#pragma unroll
            for (int n = 0; n < 4; ++n)
#pragma unroll
                for (int kk = 0; kk < 2; ++kk) Kf[n][kk] = *(const bf16x8*)(sK + (16 * n + fr) * 128 + (((kk * 4 + fq) ^ (fr & 7)) << 4));
            bf16x8 Pf[2][2];
#pragma unroll
            for (int m = 0; m < 2; ++m) {
                f32x4 s[4];
#pragma unroll
                for (int n = 0; n < 4; ++n) {
                    s[n] = (f32x4){0.f, 0.f, 0.f, 0.f};
#pragma unroll
                    for (int kk = 0; kk < 2; ++kk) s[n] = __builtin_amdgcn_mfma_f32_16x16x32_bf16(Kf[n][kk], Qf[m][kk], s[n], 0, 0, 0);
                }
                if (lat && (ti == 0 || ti == 4)) {
                    const int qpos = q0 + mo + 16 * m + fr, kb = tok0 - CTX;
#pragma unroll
                    for (int n = 0; n < 4; ++n)
#pragma unroll
                        for (int j = 0; j < 4; ++j) {
                            const int dd = qpos - (kb + 16 * n + 4 * fq + j);
                            if (dd > 128 || dd < -128) s[n][j] = -1e30f;
                        }
                }
                float mx = s[0][0];
#pragma unroll
                for (int n = 0; n < 4; ++n)
#pragma unroll
                    for (int j = 0; j < 4; ++j) mx = fmaxf(mx, s[n][j]);
                mx = rowmax4(mx);
                const float mnew = fmaxf(mrow[m], mx);
                const float alpha = __builtin_amdgcn_exp2f(mrow[m] - mnew);
                mrow[m] = mnew;
                float ls = 0.f;
#pragma unroll
                for (int n = 0; n < 4; ++n)
#pragma unroll
                    for (int j = 0; j < 4; ++j) { s[n][j] = __builtin_amdgcn_exp2f(s[n][j] - mnew); ls += s[n][j]; }
                lrow[m] = lrow[m] * alpha + ls;
#pragma unroll
                for (int nd = 0; nd < 4; ++nd) O[nd][m] *= alpha;
#pragma unroll
                for (int kk = 0; kk < 2; ++kk) {
                    union { uint4 u; bf16x8 v; } cv;
                    cv.u.x = pk2(s[2 * kk][0], s[2 * kk][1]); cv.u.y = pk2(s[2 * kk][2], s[2 * kk][3]);
                    cv.u.z = pk2(s[2 * kk + 1][0], s[2 * kk + 1][1]); cv.u.w = pk2(s[2 * kk + 1][2], s[2 * kk + 1][3]);
                    Pf[m][kk] = cv.v;
                }
            }
#pragma unroll
            for (int nd = 0; nd < 4; ++nd)
#pragma unroll
                for (int kk = 0; kk < 2; ++kk) {
                    const int row = 16 * nd + fr, x2 = 2 * ((row >> 1) & 7);
                    const uint2 lo = *(const uint2*)(sV + row * 128 + (((8 * kk + fq) ^ x2) << 3));
                    const uint2 hi = *(const uint2*)(sV + row * 128 + (((8 * kk + 4 + fq) ^ x2) << 3));
                    union { uint4 u; bf16x8 v; } cv;
                    cv.u.x = lo.x; cv.u.y = lo.y; cv.u.z = hi.x; cv.u.w = hi.y;
#pragma unroll
                    for (int m = 0; m < 2; ++m) O[nd][m] = __builtin_amdgcn_mfma_f32_16x16x32_bf16(cv.v, Pf[m][kk], O[nd][m], 0, 0, 0);
                }
        }
#pragma unroll
        for (int m = 0; m < 2; ++m) {
            float l = lrow[m];
            l = rowsum4(l);
            const float inv = __builtin_amdgcn_rcpf(l);
            uint2 og4[4];
#pragma unroll
            for (int nd = 0; nd < 4; ++nd) {
                const size_t off = (size_t)(mo + 16 * m + fr) * 1024 + 16 * nd + 4 * fq;
                const uint2 g = *(const uint2*)(SGT + off);
                const f32x4 v = O[nd][m] * inv;
                og4[nd].x = pk2(v[0] * bflo(g.x), v[1] * bfhi(g.x)); og4[nd].y = pk2(v[2] * bflo(g.y), v[3] * bfhi(g.y));
            }
#pragma unroll
            for (int nd = 0; nd < 4; nd += 2)
                *(uint4*)(OG + (size_t)(mo + 16 * m + fr) * 1024 + 16 * (nd + (fq & 1)) + 8 * (fq >> 1)) = widen16(og4[nd], og4[nd + 1]);
        }
    }
}

#define XB_TMO      128
#define XB_XCNT(j)  (256  + 64 * (j))
#define XB_XSUB(j)  (1280 + 64 * (j))
#define XB_XGEN(j)  (2304 + 64 * (j))
#define XB_TOP      3328
#define XB_TOPGEN   3392
#define XCD_BAR_WORDS 3456
#define XB_SPIN_CAP (1u << 22)
constexpr size_t OFF_BAR = OFF_ROPE + 32 * 1024;
DEVI unsigned xb_ld(unsigned* p) { return __hip_atomic_load(p, __ATOMIC_RELAXED, __HIP_MEMORY_SCOPE_AGENT); }
DEVI unsigned xb_add(unsigned* p, unsigned v) { return __hip_atomic_fetch_add(p, v, __ATOMIC_RELAXED, __HIP_MEMORY_SCOPE_AGENT); }
#define XB_SPIN(cond, bar) do { unsigned _sp = 0; while (cond) { __builtin_amdgcn_s_sleep(1); \
    if ((++_sp & 255u) == 0u) { if (xb_ld(&(bar)[XB_TMO])) break; if (_sp > XB_SPIN_CAP) { atomicAdd(&(bar)[XB_TMO], 1u); break; } } } } while (0)
struct XB { unsigned* bar; unsigned x, nloc, nx; };
DEVI void xb_post(XB& b, unsigned* bar) {
    b.bar = bar; b.nloc = 0u; b.nx = 0u;
    b.x = (unsigned)__builtin_amdgcn_s_getreg((3 << 11) | 20) & 0xFu;
    if (threadIdx.x == 0) (void)xb_add(&bar[XB_XCNT(b.x)], 1u);
}
DEVI void xb_complete(XB& b) {
    const unsigned G = gridDim.x;
    unsigned sum, cnt, mine, sp = 0u;
    for (;;) {
        sum = 0u; cnt = 0u; mine = 0u;
#pragma unroll
        for (unsigned j = 0; j < 16; ++j) { const unsigned c = xb_ld(&b.bar[XB_XCNT(j)]); sum += c; cnt += (c > 0u) ? 1u : 0u; mine = (j == b.x) ? c : mine; }
        if (sum == G) break;
        __builtin_amdgcn_s_sleep(1);
        if ((++sp & 255u) == 0u) { if (xb_ld(&b.bar[XB_TMO])) break; if (sp > XB_SPIN_CAP) { atomicAdd(&b.bar[XB_TMO], 1u); break; } }
    }
    b.nloc = mine > 0u ? mine : 1u; b.nx = cnt > 0u ? cnt : 1u;
}
DEVI void gsync(XB& b) {
    asm volatile("s_waitcnt vmcnt(0)" ::: "memory");
    __syncthreads();
    if (threadIdx.x == 0) {
        unsigned* bar = b.bar;
        __builtin_amdgcn_s_waitcnt(0);
        if (b.nloc == 0u) xb_complete(b);
        const unsigned nloc = b.nloc, nx = b.nx;
        const unsigned old = xb_add(&bar[XB_XSUB(b.x)], 1u);
        const unsigned gen = old / nloc;
        if (old + 1u == (gen + 1u) * nloc) {
            __builtin_amdgcn_fence(__ATOMIC_RELEASE, "agent");
            asm volatile("s_waitcnt vmcnt(0)" ::: "memory");
            const unsigned og = xb_add(&bar[XB_TOP], 1u);
            const unsigned tg = og / nx;
            if (og + 1u == (tg + 1u) * nx) xb_add(&bar[XB_TOPGEN], 1u);
            else XB_SPIN(xb_ld(&bar[XB_TOPGEN]) == tg, bar);
            __builtin_amdgcn_fence(__ATOMIC_ACQUIRE, "agent");
            xb_add(&bar[XB_XGEN(b.x)], 1u);
            asm volatile("s_waitcnt vmcnt(0)" ::: "memory");
        } else {
            XB_SPIN(xb_ld(&bar[XB_XGEN(b.x)]) == gen, bar);
            __builtin_amdgcn_fence(__ATOMIC_ACQUIRE, "agent");
            asm volatile("s_waitcnt vmcnt(0)" ::: "memory");
        }
    }
    __syncthreads();
}

__global__ void __launch_bounds__(256, 2) fwd_megakernel(P p) {
    cg::grid_group cgrid = cg::this_grid();
    extern __shared__ __attribute__((aligned(16))) char smem[];
    if (p.ws == nullptr) cgrid.sync();
    XB grid; xb_post(grid, (unsigned*)(p.ws + OFF_BAR));
    const int G = gridDim.x, bid = blockIdx.x;
    char* ws = p.ws;
    bf16_t* const bufA = (bf16_t*)(ws + OFF_A);
    bf16_t* const bufB = (bf16_t*)(ws + OFF_B);
    bf16_t* const bufC = (bf16_t*)(ws + OFF_C);
    bf16_t* const bufD = (bf16_t*)(ws + OFF_D);
    bf16_t* const PQT = (bf16_t*)(ws + OFF_E);
    bf16_t* const PQTC = (bf16_t*)(ws + OFF_E + 128 * MiB);
    const bf16_t* W0T = (const bf16_t*)(ws + OFF_W0T);
    const bf16_t* WO0T = (const bf16_t*)(ws + OFF_WO0T);
    const bf16_t* W1T = (const bf16_t*)(ws + OFF_W1T);
    const bf16_t* WO1T = (const bf16_t*)(ws + OFF_WO1T);
    const bf16_t* DC = (const bf16_t*)(ws + OFF_DC);

    for (int it = bid; it < 384 + 512; it += G) {
        if (it < 384) mods_item(p, it, (float*)smem);
        else wcs_item(p, it - 384);
    }
    gsync(grid);
    for (int it = bid; it < 256 + 2240 + 1280 + 1 + NR / 8; it += G) {
        if (it < 256) compose_item(p, it, (float*)smem);
        else if (it < 256 + 2240) transpose_job(p, it - 256, (float*)smem);
        else if (it < 256 + 2240 + 1280) dft_row_item(p, it - 256 - 2240);
        else if (it < 256 + 2240 + 1280 + 1) rope_item(p);
        else h0_rows(p, it - 256 - 2240 - 1280 - 1);
    }
    gsync(grid);
    for (int it = G - 1 - bid; it < 128; it += G) hfold_item(p, it, (float*)smem);
    {
        EpiG0A ea{bufB, bufC, bufD};
        EpiG0B eb{PQT, PQTC};
        constexpr int NT2 = 136 * 24 + 128;
        auto desc = [&](int L, G2Tile& t) {
            int pm, pn;
            if (L < 136 * 24) { tile_map(L, 136, 24, pm, pn); t.Bt = W0T + (size_t)pn * 128 * 1024; t.aux = 1; }
            else { const int j = L - 136 * 24; pm = (j >> 4) * 17; pn = j & 15; t.Bt = W0T + (size_t)(3072 + pn * 128) * 1024; t.aux = 0; }
            t.A = bufA + (size_t)pm * 256 * 1024; t.lda = 1024; t.ldb = 1024; t.nk = 32; t.row0 = pm * 256; t.col0 = pn * 128;
        };
        int st = 0;
        G2Tile t, nx;
        if (bid < NT2) { desc(bid, t); __syncthreads(); g2_prologue(t, 0, smem); }
        for (int L = bid; L < NT2; L += G) {
            const bool hn = L + G < NT2;
            if (hn) desc(L + G, nx);
            if (t.aux) st = g2_body<true>(t, st, smem, hn, nx, ea); else st = g2_body<false>(t, st, smem, hn, nx, eb);
            t = nx;
        }
    }
    gsync(grid);
    if (bid < (G >> 1)) {
    {
        __builtin_amdgcn_s_setprio(2);
        int cur_h = -1; uint4 u0, u1, u2; float cpre = 0.f;
        if (bid < NB * NCH * 16) lru_load_us(p, bid, threadIdx.x, u0, u1, u2);
        for (int it = bid; it < NB * NCH * 16; it += G) {
            if ((it & 15) != cur_h) { cur_h = it & 15; lru_preload(p, cur_h, smem); }
            lru_item<false>(p, it, it + G < NB * NCH * 16 ? it + G : -1, u0, u1, u2, cpre, smem);
        }
        __builtin_amdgcn_s_setprio(0);
    }
    for (int it = bid; it < 512; it += G) fspecial_item(p, it, (float*)smem);
    {
        int st = 0; G2Tile t, nx;
        auto desc = [&](int L, G2Tile& q) { const int b = L >> 7, fam = (L >> 5) & 3; int pm, pn; tile_map(L & 31, 4, 8, pm, pn);
            q.A = (const bf16_t*)(ws + OFF_HF) + ((size_t)(b * 4 + fam) * 1024 + pm * 256) * 1024;
            q.Bt = W0T + (size_t)(3072 + (fam >> 1) * 1024 + pn * 128) * 1024;
            q.lda = 1024; q.ldb = 1024; q.nk = 32; q.row0 = pm * 256; q.col0 = pn * 128; q.aux = b * 4 + fam; };
        if (bid < 1024) { desc(bid, t); __syncthreads(); g2_prologue(t, 0, smem); }
        for (int L = bid; L < 1024; L += G) {
            const bool hn = L + G < 1024;
            if (hn) desc(L + G, nx);
            const int b = t.aux >> 2, fam = t.aux & 3;
            EpiFoldT ef{(bf16_t*)(ws + ((fam & 2) ? OFF_QF : OFF_PE) + (size_t)(fam & 1) * 16 * MiB) + (size_t)b * 1048576};
            st = g2_body<false>(t, st, smem, hn, nx, ef);
            t = nx;
        }
        EpiDFT edc{bufD, p.b_f, 0.005524271728019903f  };
        for (int L = G - 1 - bid; L < 128; L += G) {
            const int b = L >> 4, pm = (L >> 3) & 1, pn = L & 7;
            gemm_tile<true>(DC + (size_t)pm * 128 * 512, DC, 1 << 30, 512, PQTC + (size_t)(b * 1024 + pn * 128) * 512, 512, 8, smem, edc, b * TPB + pm * 128, pn * 128);
        }
    }
    } else {
    for (int it = bid; it < 512; it += G) fspecial_item(p, it, (float*)smem);
    {
        int st = 0; G2Tile t, nx;
        auto desc = [&](int L, G2Tile& q) { const int b = L >> 7, fam = (L >> 5) & 3; int pm, pn; tile_map(L & 31, 4, 8, pm, pn);
            q.A = (const bf16_t*)(ws + OFF_HF) + ((size_t)(b * 4 + fam) * 1024 + pm * 256) * 1024;
            q.Bt = W0T + (size_t)(3072 + (fam >> 1) * 1024 + pn * 128) * 1024;
            q.lda = 1024; q.ldb = 1024; q.nk = 32; q.row0 = pm * 256; q.col0 = pn * 128; q.aux = b * 4 + fam; };
        if (bid < 1024) { desc(bid, t); __syncthreads(); g2_prologue(t, 0, smem); }
        for (int L = bid; L < 1024; L += G) {
            const bool hn = L + G < 1024;
            if (hn) desc(L + G, nx);
            const int b = t.aux >> 2, fam = t.aux & 3;
            EpiFoldT ef{(bf16_t*)(ws + ((fam & 2) ? OFF_QF : OFF_PE) + (size_t)(fam & 1) * 16 * MiB) + (size_t)b * 1048576};
            st = g2_body<false>(t, st, smem, hn, nx, ef);
            t = nx;
        }
        EpiDFT edc{bufD, p.b_f, 0.005524271728019903f  };
        for (int L = G - 1 - bid; L < 128; L += G) {
            const int b = L >> 4, pm = (L >> 3) & 1, pn = L & 7;
            gemm_tile<true>(DC + (size_t)pm * 128 * 512, DC, 1 << 30, 512, PQTC + (size_t)(b * 1024 + pn * 128) * 512, 512, 8, smem, edc, b * TPB + pm * 128, pn * 128);
        }
    }
    {
        __builtin_amdgcn_s_setprio(2);
        int cur_h = -1; uint4 u0, u1, u2; float cpre = 0.f;
        if (bid < NB * NCH * 16) lru_load_us(p, bid, threadIdx.x, u0, u1, u2);
        for (int it = bid; it < NB * NCH * 16; it += G) {
            if ((it & 15) != cur_h) { cur_h = it & 15; lru_preload(p, cur_h, smem); }
            lru_item<false>(p, it, it + G < NB * NCH * 16 ? it + G : -1, u0, u1, u2, cpre, smem);
        }
        __builtin_amdgcn_s_setprio(0);
    }
    }
    gsync(grid);
    for (int it = bid; it < 64; it += G) lru_carry_item(p, it);
    gsync(grid);
    if (bid < (G >> 1)) {
    {
        int st = 0; G2Tile tc, ts, nx;
        auto desc = [&](int L, int sn, G2Tile& q) { const int b = L >> 6, par = (L >> 5) & 1; int pm, pn; tile_map(L & 31, 4, 8, pm, pn);
            q.A = (const bf16_t*)(ws + OFF_DL + (size_t)(2 * sn + par) * 2 * MiB) + (size_t)pm * 256 * 1024;
            q.Bt = (const bf16_t*)(ws + (sn ? OFF_QF : OFF_PE) + (size_t)par * 16 * MiB) + (size_t)(b * 1024 + pn * 128) * 1024;
            q.lda = 1024; q.ldb = 1024; q.nk = 32; q.row0 = pm * 256; q.col0 = pn * 128; q.aux = b * 2 + par; };
        if (bid < 512) { desc(bid, 0, tc); __syncthreads(); g2_prologue(tc, 0, smem); }
        for (int L = bid; L < 512; L += G) {
            desc(L, 1, ts);
            const bool hn = L + G < 512;
            if (hn) desc(L + G, 0, nx);
            EpiYc eyc{(float*)(ws + OFF_T), (const float*)(ws + OFF_PS1024), tc.aux >> 1, tc.aux & 1};
            st = g2_body<true>(tc, st, smem, true, ts, eyc);
            EpiYs eys{(const float*)(ws + OFF_T), bufD, p.b_f, 0.0013810679320049757f  , (const float*)(ws + OFF_QS1024), ts.aux >> 1, ts.aux & 1};
            st = g2_body<true>(ts, st, smem, hn, nx, eys);
            tc = nx;
        }
    }
    {
        __builtin_amdgcn_s_setprio(2);
        int cur_h = -1; uint4 u0, u1, u2; float cpre = 0.f;
        if (bid < NB * NCH * 16) {
            lru_load_us(p, bid, threadIdx.x, u0, u1, u2);
            if (threadIdx.x < 128) { const int nh = bid & 15, nc = (bid >> 4) % NCH, nb = bid / (16 * NCH);
                cpre = ((const float*)(ws + OFF_CIN))[(size_t)(nb * NCH + nc) * 2048 + (threadIdx.x >> 6) * 1024 + nh * 64 + (threadIdx.x & 63)]; }
        }
        for (int it = bid; it < NB * NCH * 16; it += G) {
            if ((it & 15) != cur_h) { cur_h = it & 15; lru_preload(p, cur_h, smem); }
            lru_item<true>(p, it, it + G < NB * NCH * 16 ? it + G : -1, u0, u1, u2, cpre, smem);
        }
        __builtin_amdgcn_s_setprio(0);
    }
    } else {
    {
        __builtin_amdgcn_s_setprio(2);
        int cur_h = -1; uint4 u0, u1, u2; float cpre = 0.f;
        if (bid < NB * NCH * 16) {
            lru_load_us(p, bid, threadIdx.x, u0, u1, u2);
            if (threadIdx.x < 128) { const int nh = bid & 15, nc = (bid >> 4) % NCH, nb = bid / (16 * NCH);
                cpre = ((const float*)(ws + OFF_CIN))[(size_t)(nb * NCH + nc) * 2048 + (threadIdx.x >> 6) * 1024 + nh * 64 + (threadIdx.x & 63)]; }
        }
        for (int it = bid; it < NB * NCH * 16; it += G) {
            if ((it & 15) != cur_h) { cur_h = it & 15; lru_preload(p, cur_h, smem); }
            lru_item<true>(p, it, it + G < NB * NCH * 16 ? it + G : -1, u0, u1, u2, cpre, smem);
        }
        __builtin_amdgcn_s_setprio(0);
    }
    {
        int st = 0; G2Tile tc, ts, nx;
        auto desc = [&](int L, int sn, G2Tile& q) { const int b = L >> 6, par = (L >> 5) & 1; int pm, pn; tile_map(L & 31, 4, 8, pm, pn);
            q.A = (const bf16_t*)(ws + OFF_DL + (size_t)(2 * sn + par) * 2 * MiB) + (size_t)pm * 256 * 1024;
            q.Bt = (const bf16_t*)(ws + (sn ? OFF_QF : OFF_PE) + (size_t)par * 16 * MiB) + (size_t)(b * 1024 + pn * 128) * 1024;
            q.lda = 1024; q.ldb = 1024; q.nk = 32; q.row0 = pm * 256; q.col0 = pn * 128; q.aux = b * 2 + par; };
        if (bid < 512) { desc(bid, 0, tc); __syncthreads(); g2_prologue(tc, 0, smem); }
        for (int L = bid; L < 512; L += G) {
            desc(L, 1, ts);
            const bool hn = L + G < 512;
            if (hn) desc(L + G, 0, nx);
            EpiYc eyc{(float*)(ws + OFF_T), (const float*)(ws + OFF_PS1024), tc.aux >> 1, tc.aux & 1};
            st = g2_body<true>(tc, st, smem, true, ts, eyc);
            EpiYs eys{(const float*)(ws + OFF_T), bufD, p.b_f, 0.0013810679320049757f  , (const float*)(ws + OFF_QS1024), ts.aux >> 1, ts.aux & 1};
            st = g2_body<true>(ts, st, smem, hn, nx, eys);
            tc = nx;
        }
    }
    }
    gsync(grid);
    {
        EpiBf16 ef{(bf16_t*)(ws + OFF_E)};
        for (int L = bid; L < 272 * 8; L += G) {
            int pm, pn; tile_map(L, 272, 8, pm, pn);
            gemm_tile<true>(bufA + (size_t)pm * 128 * 1024, bufD + (size_t)pm * 128 * 1024, 16, 1024, WO0T + (size_t)pn * 128 * 2048, 2048, 32, smem, ef, pm * 128, pn * 128);
        }
    }
    gsync(grid);
    for (int it = bid; it < NR / 8; it += G) norm1_rows(p, it);
    gsync(grid);
    {
        EpiG2A ea{bufB, bufD, bufC, (const float*)(ws + OFF_ROPE), (const float*)(ws + OFF_ROPE) + 1024};
        for (int L = bid; L < 272 * 18; L += G) {
            int pm, pn; tile_map(L, 272, 18, pm, pn);
            const bool isctx = (pm % 34) < 2;
            if (isctx && (pn < 8 || pn > 9)) continue;
            gemm_tile<true>(bufA + (size_t)pm * 128 * 1024, bufA, 1 << 30, 1024, W1T + (size_t)pn * 128 * 1024, 1024, 16, smem, ea, pm * 128, pn * 128);
        }
        EpiG2B eb{(bf16_t*)(ws + OFF_D + 17 * MiB)};
        for (int L = bid; L < 272 * 2; L += G) {
            int pm, pn; tile_map(L, 272, 2, pm, pn);
            gemm_tile<false>(bufA + (size_t)pm * 128 * 1024, bufA, 1 << 30, 1024, W1T + (size_t)(2304 + pn * 128) * 1024, 1024, 16, smem, eb, pm * 128, pn * 128);
        }
    }
    gsync(grid);
    for (int it = bid; it < NB * 4 * 64; it += G) attn_item(p, it, smem);
    gsync(grid);
    {
        EpiBf16 ef{(bf16_t*)(ws + OFF_E)};
        {
            int st = 0; G2Tile t, nx;
            auto desc = [&](int L, G2Tile& q) { int pm, pn; tile_map(L, 128, 8, pm, pn);
                q.A = bufA + (size_t)pm * 256 * 1024; q.Bt = WO1T + (size_t)pn * 128 * 1024; q.lda = 1024; q.ldb = 1024; q.nk = 32; q.row0 = pm * 256; q.col0 = pn * 128; q.aux = 0; };
            if (bid < 1024) { desc(bid, t); __syncthreads(); g2_prologue(t, 0, smem); }
            for (int L = bid; L < 1024; L += G) {
                const bool hn = L + G < 1024;
                if (hn) desc(L + G, nx);
                st = g2_body<true>(t, st, smem, hn, nx, ef);
                t = nx;
            }
        }
    }
    gsync(grid);
    for (int it = bid; it < NB * SEQ / 8; it += G) final_rows(p, it);
}

extern "C" void kernel_launch(void* const* d_in, const int* in_sizes, int n_in, void* d_out, int out_size, void* d_ws, size_t ws_size,
                              hipStream_t stream) {
    static int grid_blocks = 0;
    if (!grid_blocks) {
        int dev = 0, cus = 0, per_cu = 0;
        (void)hipGetDevice(&dev);
        (void)hipDeviceGetAttribute(&cus, hipDeviceAttributeMultiprocessorCount, dev);
        (void)hipFuncSetAttribute((const void*)fwd_megakernel, hipFuncAttributeMaxDynamicSharedMemorySize, 73728);
        (void)hipOccupancyMaxActiveBlocksPerMultiprocessor(&per_cu, fwd_megakernel, 256, 73728);
        if (per_cu > 2) per_cu = 2;
        if (per_cu < 1) per_cu = 1;
        grid_blocks = cus * per_cu;
    }
    P p{};
    const float* const* in = (const float* const*)d_in;
    p.x = in[0]; p.c = in[1]; p.ctx = in[2]; p.c_ctx = in[3];
    p.w_mod0 = in[4]; p.b_mod0 = in[5]; p.g_pre0 = in[6]; p.g_post0 = in[7]; p.w_in0 = in[8]; p.w_conv = in[9]; p.b_conv = in[10];
    p.w_a = in[11]; p.b_a = in[12]; p.w_x = in[13]; p.b_x = in[14]; p.lam = in[15]; p.w_f = in[16]; p.b_f = in[17]; p.w_out0 = in[18];
    p.w_mod1 = in[19]; p.b_mod1 = in[20]; p.g_pre1 = in[21]; p.g_post1 = in[22]; p.w_in1 = in[23]; p.sink = in[24]; p.w_out1 = in[25];
    p.out = (float*)d_out;
    p.ws = (char*)d_ws;
    void* args[] = {&p};
    (void)hipMemsetAsync((char*)d_ws + OFF_BAR, 0, XCD_BAR_WORDS * 4, stream);
    hipError_t e = hipLaunchCooperativeKernel((void*)fwd_megakernel, dim3(grid_blocks), dim3(256), args, 73728, stream);
    if (e != hipSuccess) fprintf(stderr, "cooperative launch failed: %s (grid %d)\n", hipGetErrorString(e), grid_blocks);
}
```
